# Optimizing an MI355X kernel written in HIP

```python
import math
import jax, jax.numpy as jnp
from jax import lax
import numpy as np

D_MODEL = 1024
BATCH = 1
SEQ = 16384
DEPTH = 2
DEC_BATCH = 8
DEC_SEQ = 64
PAST_LEN = 2048

CHUNK = 64
N_MIXERS = 2
N_A_LAYERS = (DEPTH + 1) // 2
N_B_LAYERS = DEPTH // 2
EPS = 1e-6
GDN_HEADS = 8
GDN_DK = 128
GDN_DV = 128
GDN_CONV = 4
GDN_QKV = GDN_HEADS * (2 * GDN_DK + GDN_DV)
GDN_VW = GDN_HEADS * GDN_DV
SWA_HEADS = 16
SWA_KV_HEADS = 4
SWA_HD = 64
WINDOW = 128
N_MEM = 256
MEM_HEADS = 4
MEM_HD = 128
MEM_W = MEM_HEADS * MEM_HD
IN_A = GDN_QKV + GDN_VW + 2 * GDN_HEADS + MEM_W
IN_B = (SWA_HEADS + 2 * SWA_KV_HEADS) * SWA_HD + MEM_W
SPLIT_A = (GDN_QKV, GDN_QKV + GDN_VW, GDN_QKV + GDN_VW + GDN_HEADS, GDN_QKV + GDN_VW + 2 * GDN_HEADS)
SPLIT_B = (SWA_HEADS * SWA_HD, (SWA_HEADS + SWA_KV_HEADS) * SWA_HD, (SWA_HEADS + 2 * SWA_KV_HEADS) * SWA_HD)
MIX_A = GDN_VW + MEM_W
MIX_B = SWA_HEADS * SWA_HD + MEM_W
D_FF = -(-8 * D_MODEL // (3 * 256)) * 256

kernel_name = 'hybrid_gdn_swa_stream_step'


def rms_norm(x, g):
    xf = x.astype(jnp.float32)
    y = xf * lax.rsqrt(jnp.mean(xf * xf, axis=-1, keepdims=True) + EPS)
    return (y * g.astype(jnp.float32)).astype(x.dtype)


def l2_norm(x):
    return x * lax.rsqrt(jnp.sum(x * x, axis=-1, keepdims=True) + EPS)


def causal_dwconv(x, conv_state, w):
    t = x.shape[1]
    xp = jnp.concatenate([conv_state.astype(x.dtype), x], axis=1)
    y = xp[:, 0:t] * w[0]
    for i in range(1, GDN_CONV):
        y = y + xp[:, i:i + t] * w[i]
    return y, xp[:, xp.shape[1] - (GDN_CONV - 1):]


def gated_delta_rule(q, k, v, g, beta, s0):
    b, t, h, _ = q.shape
    dv = v.shape[-1]
    c = min(CHUNK, t)
    n = t // c
    to_blk = lambda a: jnp.moveaxis(a.reshape((b, n, c, h) + a.shape[3:]), 3, 1)
    qb, kb, vb = to_blk(q), to_blk(k), to_blk(v)
    gb, bb = to_blk(g), to_blk(beta)
    cum = jnp.cumsum(gb, axis=-1)
    causal = jnp.tril(jnp.ones((c, c), dtype=bool))
    strict = jnp.tril(jnp.ones((c, c), dtype=bool), -1)
    decay = jnp.exp(jnp.where(causal, cum[..., :, None] - cum[..., None, :], -jnp.inf))
    k_beta = kb * bb[..., None]
    a_low = jnp.where(strict, jnp.einsum('bhnid,bhnjd->bhnij', k_beta, kb) * decay, 0.0)
    rhs = jnp.concatenate([vb * bb[..., None], k_beta * jnp.exp(cum)[..., None]], axis=-1)
    sol = lax.linalg.triangular_solve(a_low + jnp.eye(c, dtype=jnp.float32), rhs,
                                      left_side=True, lower=True, unit_diagonal=True)
    u_base, w_cum = sol[..., :dv], sol[..., dv:]
    qk = jnp.einsum('bhnid,bhnjd->bhnij', qb, kb) * decay
    q_dec = qb * jnp.exp(cum)[..., None]
    k_dec = kb * jnp.exp(cum[..., -1:] - cum)[..., None]
    a_chunk = jnp.exp(cum[..., -1])

    def step(s, xs):
        u0, wc, qkc, qd, kd, ac = xs
        u = u0 - jnp.einsum('bhck,bhkv->bhcv', wc, s)
        o = jnp.einsum('bhck,bhkv->bhcv', qd, s) + jnp.einsum('bhij,bhjv->bhiv', qkc, u)
        s = s * ac[..., None, None] + jnp.einsum('bhck,bhcv->bhkv', kd, u)
        return s, o

    xs = tuple(jnp.moveaxis(a, 2, 0) for a in (u_base, w_cum, qk, q_dec, k_dec, a_chunk))
    s_fin, o = lax.scan(step, s0, xs)
    o = jnp.transpose(o, (1, 0, 3, 2, 4)).reshape(b, t, h, dv)
    return o, s_fin


def gdn_mixer(qkv, z, b_raw, a_raw, conv_state, s0, conv_w, a_log, dt_bias, o_gain):
    bsz, t, _ = qkv.shape
    qkv, conv_new = causal_dwconv(qkv, conv_state, conv_w)
    qkv = jax.nn.silu(qkv).astype(jnp.float32)
    q, k, v = jnp.split(qkv, [GDN_HEADS * GDN_DK, 2 * GDN_HEADS * GDN_DK], axis=-1)
    q = l2_norm(q.reshape(bsz, t, GDN_HEADS, GDN_DK)) * (GDN_DK ** -0.5)
    k = l2_norm(k.reshape(bsz, t, GDN_HEADS, GDN_DK))
    v = v.reshape(bsz, t, GDN_HEADS, GDN_DV)
    beta = jax.nn.sigmoid(b_raw.astype(jnp.float32))
    g = -jnp.exp(a_log.astype(jnp.float32)) * jax.nn.softplus(a_raw.astype(jnp.float32) + dt_bias.astype(jnp.float32))
    o, s_new = gated_delta_rule(q, k, v, g, beta, s0.astype(jnp.float32))
    o = rms_norm(o.astype(z.dtype), o_gain) * jax.nn.silu(z.reshape(bsz, t, GDN_HEADS, GDN_DV))
    return o.reshape(bsz, t, GDN_VW), conv_new, s_new.astype(s0.dtype)


def swa_mixer(q, k, v, k_hist, v_hist, hist_valid, q_gain, k_gain, sinks):
    bsz, t, _ = q.shape
    grp = SWA_HEADS // SWA_KV_HEADS
    q = rms_norm(q.reshape(bsz, t, SWA_HEADS, SWA_HD), q_gain)
    k = rms_norm(k.reshape(bsz, t, SWA_KV_HEADS, SWA_HD), k_gain)
    v = v.reshape(bsz, t, SWA_KV_HEADS, SWA_HD)
    lh = k_hist.shape[1]
    c = min(CHUNK, t)
    n = t // c
    kp = jnp.concatenate([k_hist.astype(k.dtype), k], axis=1)
    vp = jnp.concatenate([v_hist.astype(v.dtype), v], axis=1)
    idx = (jnp.arange(n) * c)[:, None] + jnp.arange(lh + c)[None, :]
    kb, vb = kp[:, idx], vp[:, idx]
    valid = idx >= (0 if hist_valid else lh)
    qb = q.reshape(bsz, n, c, SWA_KV_HEADS, grp, SWA_HD)
    s = jnp.einsum('bnqhgd,bnkhd->bnhgqk', qb, kb).astype(jnp.float32) * (SWA_HD ** -0.5)
    s = jnp.where(valid[None, :, None, None, None, :], s, -jnp.inf)
    sink = sinks.astype(jnp.float32).reshape(1, 1, SWA_KV_HEADS, grp, 1, 1)
    m = jnp.maximum(jnp.max(s, axis=-1, keepdims=True), sink)
    p = jnp.exp(s - m)
    p = p / (jnp.sum(p, axis=-1, keepdims=True) + jnp.exp(sink - m))
    o = jnp.einsum('bnhgqk,bnkhd->bnqhgd', p.astype(v.dtype), vb)
    return o.reshape(bsz, t, SWA_HEADS * SWA_HD), k, v


def memory_kv(mem, norm_g, w_kv, k_gain):
    bsz, nm, _ = mem.shape
    kv = rms_norm(mem, norm_g) @ w_kv
    mk, mv = jnp.split(kv, 2, axis=-1)
    mk = rms_norm(mk.reshape(bsz, nm, MEM_HEADS, MEM_HD), k_gain)
    return mk, mv.reshape(bsz, nm, MEM_HEADS, MEM_HD)


def memory_attend(qm, mk, mv, q_gain):
    bsz, t, _ = qm.shape
    qm = rms_norm(qm.reshape(bsz, t, MEM_HEADS, MEM_HD), q_gain)
    s = jnp.einsum('bqhd,bkhd->bhqk', qm, mk.astype(qm.dtype)).astype(jnp.float32) * (MEM_HD ** -0.5)
    p = jax.nn.softmax(s, axis=-1).astype(qm.dtype)
    return jnp.einsum('bhqk,bkhd->bqhd', p, mv.astype(qm.dtype)).reshape(bsz, t, MEM_W)


def trunk(x, mem_k, mem_v, gdn_conv, gdn_state, swa_k_hist, swa_v_hist, hist_valid, p):
    conv_out, state_out, k_out, v_out = [], [], [], []
    for i in range(DEPTH):
        j = i // N_MIXERS
        h = rms_norm(x, p['norm_mix'][i])
        if i % N_MIXERS == 0:
            proj = h @ p['w_in_a'][j]
            qkv, z, b_raw, a_raw, qm = jnp.split(proj, SPLIT_A, axis=-1)
            o_mix, conv_new, s_new = gdn_mixer(qkv, z, b_raw, a_raw, gdn_conv[j], gdn_state[j], p['conv_w_a'][j],
                                               p['a_log'][j], p['dt_bias'][j], p['o_norm_a'][j])
            conv_out.append(conv_new)
            state_out.append(s_new)
            w_out = p['w_out_a'][j]
        else:
            proj = h @ p['w_in_b'][j]
            q, k, v, qm = jnp.split(proj, SPLIT_B, axis=-1)
            o_mix, k_new, v_new = swa_mixer(q, k, v, swa_k_hist[j], swa_v_hist[j], hist_valid,
                                            p['q_norm_b'][j], p['k_norm_b'][j], p['sinks_b'][j])
            k_out.append(k_new)
            v_out.append(v_new)
            w_out = p['w_out_b'][j]
        o_mem = memory_attend(qm, mem_k[i], mem_v[i], p['mem_q_norm'][i])
        x = x + jnp.concatenate([o_mix, o_mem.astype(o_mix.dtype)], axis=-1) @ w_out
        h = rms_norm(x, p['norm_ffn'][i])
        gate, up = jnp.split(h @ p['w_gate_up'][i], 2, axis=-1)
        x = x + (jax.nn.silu(gate) * up) @ p['w_down'][i]
    return x, jnp.stack(conv_out), jnp.stack(state_out), jnp.stack(k_out), jnp.stack(v_out)


def setup_inputs(seed: int = 0) -> dict:
    key = jax.random.key(seed)
    ks = iter(jax.random.split(key, 32))
    nrm = lambda shape, scale: jax.random.normal(next(ks), shape, jnp.float32) * scale
    gain = lambda shape: 1.0 + nrm(shape, 0.02)
    swa_rows = min(WINDOW, PAST_LEN)
    dt0 = jnp.exp(jax.random.uniform(next(ks), (N_A_LAYERS, GDN_HEADS), jnp.float32, math.log(1e-3), math.log(1e-1)))
    return {
        'x_prompt': nrm((BATCH, SEQ, D_MODEL), 1.0),
        'x_sample': nrm((DEC_BATCH, DEC_SEQ, D_MODEL), 1.0),
        'mem_prompt': nrm((BATCH, N_MEM, D_MODEL), 1.0),
        'cache_mem_k': nrm((DEPTH, DEC_BATCH, N_MEM, MEM_HEADS, MEM_HD), 1.0),
        'cache_mem_v': nrm((DEPTH, DEC_BATCH, N_MEM, MEM_HEADS, MEM_HD), 1.0),
        'state_gdn': nrm((N_A_LAYERS, DEC_BATCH, GDN_HEADS, GDN_DK, GDN_DV), 0.1),
        'state_gdn_conv': nrm((N_A_LAYERS, DEC_BATCH, GDN_CONV - 1, GDN_QKV), 1.0),
        'cache_swa_k': nrm((N_B_LAYERS, DEC_BATCH, swa_rows, SWA_KV_HEADS, SWA_HD), 1.0),
        'cache_swa_v': nrm((N_B_LAYERS, DEC_BATCH, swa_rows, SWA_KV_HEADS, SWA_HD), 1.0),
        'norm_mix': gain((DEPTH, D_MODEL)),
        'norm_ffn': gain((DEPTH, D_MODEL)),
        'mem_norm': gain((DEPTH, D_MODEL)),
        'w_mem_kv': nrm((DEPTH, D_MODEL, 2 * MEM_W), D_MODEL ** -0.5),
        'mem_q_norm': gain((DEPTH, MEM_HD)),
        'mem_k_norm': gain((DEPTH, MEM_HD)),
        'w_in_a': nrm((N_A_LAYERS, D_MODEL, IN_A), D_MODEL ** -0.5),
        'conv_w_a': nrm((N_A_LAYERS, GDN_CONV, GDN_QKV), GDN_CONV ** -0.5),
        'a_log': jnp.log(jax.random.uniform(next(ks), (N_A_LAYERS, GDN_HEADS), jnp.float32, 1.0, 16.0)),
        'dt_bias': dt0 + jnp.log(-jnp.expm1(-dt0)),
        'o_norm_a': gain((N_A_LAYERS, GDN_DV)),
        'w_out_a': nrm((N_A_LAYERS, MIX_A, D_MODEL), MIX_A ** -0.5),
        'w_in_b': nrm((N_B_LAYERS, D_MODEL, IN_B), D_MODEL ** -0.5),
        'q_norm_b': gain((N_B_LAYERS, SWA_HD)),
        'k_norm_b': gain((N_B_LAYERS, SWA_HD)),
        'sinks_b': nrm((N_B_LAYERS, SWA_HEADS), 1.0),
        'w_out_b': nrm((N_B_LAYERS, MIX_B, D_MODEL), MIX_B ** -0.5),
        'w_gate_up': nrm((DEPTH, D_MODEL, 2 * D_FF), D_MODEL ** -0.5),
        'w_down': nrm((DEPTH, D_FF, D_MODEL), D_FF ** -0.5),
    }


def reference(x_prompt, x_sample, mem_prompt, cache_mem_k, cache_mem_v, state_gdn, state_gdn_conv,
              cache_swa_k, cache_swa_v, norm_mix, norm_ffn, mem_norm, w_mem_kv, mem_q_norm, mem_k_norm,
              w_in_a, conv_w_a, a_log, dt_bias, o_norm_a, w_out_a, w_in_b, q_norm_b, k_norm_b, sinks_b,
              w_out_b, w_gate_up, w_down):
    p = {'norm_mix': norm_mix, 'norm_ffn': norm_ffn, 'mem_q_norm': mem_q_norm,
         'w_in_a': w_in_a, 'conv_w_a': conv_w_a, 'a_log': a_log, 'dt_bias': dt_bias,
         'o_norm_a': o_norm_a, 'w_out_a': w_out_a, 'w_in_b': w_in_b, 'q_norm_b': q_norm_b,
         'k_norm_b': k_norm_b, 'sinks_b': sinks_b, 'w_out_b': w_out_b,
         'w_gate_up': w_gate_up, 'w_down': w_down}
    bsz = x_prompt.shape[0]
    dt = x_prompt.dtype
    mk_list, mv_list = [], []
    for i in range(DEPTH):
        mk, mv = memory_kv(mem_prompt, mem_norm[i], w_mem_kv[i], mem_k_norm[i])
        mk_list.append(mk)
        mv_list.append(mv)
    new_mem_k_prompt = jnp.stack(mk_list)
    new_mem_v_prompt = jnp.stack(mv_list)
    zero_conv = jnp.zeros((N_A_LAYERS, bsz, GDN_CONV - 1, GDN_QKV), dt)
    zero_state = jnp.zeros((N_A_LAYERS, bsz, GDN_HEADS, GDN_DK, GDN_DV), dt)
    zero_hist = jnp.zeros((N_B_LAYERS, bsz, WINDOW, SWA_KV_HEADS, SWA_HD), dt)
    y_prompt, conv_p, state_p, k_p, v_p = trunk(x_prompt, new_mem_k_prompt, new_mem_v_prompt, zero_conv,
                                                zero_state, zero_hist, zero_hist, False, p)
    keep = min(WINDOW, x_prompt.shape[1])
    y_sample, conv_s, state_s, k_s, v_s = trunk(x_sample, cache_mem_k, cache_mem_v, state_gdn_conv, state_gdn,
                                                cache_swa_k, cache_swa_v, True, p)
    return (y_prompt, y_sample, state_p, conv_p, state_s, conv_s,
            k_p[:, :, -keep:], v_p[:, :, -keep:], k_s, v_s, new_mem_k_prompt, new_mem_v_prompt)
```

```cpp
#include <hip/hip_runtime.h>
#include <cstdio>
#include <cstdint>

#define LAS __attribute__((address_space(3)))
#define GAS __attribute__((address_space(1)))
typedef unsigned short bf16;
typedef short bf16x8 __attribute__((ext_vector_type(8)));
typedef short s16x4 __attribute__((ext_vector_type(4)));
typedef float f32x4 __attribute__((ext_vector_type(4)));
typedef float f32x2 __attribute__((ext_vector_type(2)));
typedef float f32x16 __attribute__((ext_vector_type(16)));
typedef unsigned u32x4 __attribute__((ext_vector_type(4)));
typedef unsigned u32x2 __attribute__((ext_vector_type(2)));
typedef GAS unsigned gu32;

#ifndef LAST_PHASE
#define LAST_PHASE 99
#endif

constexpr int D = 1024, SEQ = 16384, NTOK = 16896, NCH = 264  ;
constexpr int PITCH = 4608;
constexpr int DFF = 2816;
constexpr float EPS = 1e-6f;
constexpr int C_Z = 3072, C_QM0 = 4096;
constexpr int C_XB = 0, C_ACT = 1024, C_Q1 = 1024, C_QM1 = 2048, C_K1 = 2560, C_V1 = 2816;

constexpr size_t O_Y = 0, O_STATE_P = 17301504, O_CONV_P = 17432576, O_STATE_S = 17441792, O_CONV_S = 18490368, O_KP = 18564096, O_VP = 18596864,
                 O_KS = 18629632, O_VS = 18760704, O_MEMK = 18891776, O_MEMV = 19153920;

constexpr size_t MiB = 1u << 20;
constexpr size_t WS_CTL = 0, CTL_ZERO_BYTES = 1 * MiB;
constexpr size_t WS_ROWSS0 = 1 * MiB;
constexpr size_t WS_BA = 2 * MiB;
constexpr size_t WS_HALO = 4 * MiB;
constexpr size_t WS_KVRAW = 9 * MiB;
constexpr size_t WS_MEMB = 11 * MiB;
constexpr size_t WS_ACHUNK = 11 * MiB + 768 * 1024;
constexpr size_t WS_SWAC = 12 * MiB;
constexpr size_t WS_KVIMG = 13 * MiB;
constexpr size_t WS_MG = 22 * MiB;
constexpr size_t WS_HSLOT = 30 * MiB;
constexpr size_t WS_WA = 46 * MiB;
constexpr size_t WS_WOA = WS_WA + (size_t)4864 * 1024 * 2;
constexpr size_t WS_WGU0 = WS_WOA + (size_t)1024 * 1536 * 2;
constexpr size_t WS_WD0 = WS_WGU0 + (size_t)5632 * 1024 * 2;
constexpr size_t WS_WB = WS_WD0 + (size_t)1024 * 2816 * 2;
constexpr size_t WS_WOB = WS_WB + (size_t)2048 * 1024 * 2;
constexpr size_t WS_WGU1 = WS_WOB + (size_t)1024 * 1536 * 2;
constexpr size_t WS_WD1 = WS_WGU1 + (size_t)5632 * 1024 * 2;
constexpr size_t WS_WMEM = WS_WD1 + (size_t)1024 * 2816 * 2;
constexpr size_t WS_WEND = WS_WMEM + (size_t)2 * 1024 * 1024 * 2;
constexpr size_t WS_BIG = 103 * MiB;
constexpr size_t WS_END = WS_BIG + (size_t)NTOK * PITCH * 2;
static_assert(WS_WEND <= WS_BIG && WS_END <= 256 * MiB, "d_ws map");
constexpr int CW_BAR = 4096;
constexpr int CW_RSS1 = 65536, CW_RSS2 = CW_RSS1 + 16896, CW_RSS3 = CW_RSS2 + 16896;
static_assert((CW_RSS3 + 16896) * 4 <= (int)CTL_ZERO_BYTES, "ctl");
constexpr size_t QX_BYTES = 24576;

constexpr int RING_BYTES = 131072;
constexpr int MISC_OFF = 143360;
constexpr int LDS_BYTES = 147456;

#define RLX_AGENT __ATOMIC_RELAXED, __HIP_MEMORY_SCOPE_AGENT
#define LDS_WAIT() asm volatile("s_waitcnt lgkmcnt(0)" ::: "memory")
#define VM_WAIT() asm volatile("s_waitcnt vmcnt(0)" ::: "memory")
typedef __bf16 bf16x2_t __attribute__((ext_vector_type(2)));
__device__ __forceinline__ unsigned pk2(float lo, float hi) { f32x2 v = {lo, hi}; bf16x2_t b = __builtin_convertvector(v, bf16x2_t); return __builtin_bit_cast(unsigned, b); }
__device__ __forceinline__ float bf2f(unsigned short b) { return __uint_as_float((unsigned)b << 16); }
__device__ __forceinline__ float bflo(unsigned w) { return __uint_as_float(w << 16); }
__device__ __forceinline__ float bfhi(unsigned w) { return __uint_as_float(w & 0xffff0000u); }
__device__ __forceinline__ float wave_sum(float v) {
#pragma unroll
    for (int o = 1; o < 64; o <<= 1) v += __shfl_xor(v, o);
    return v;
}
__device__ __forceinline__ float fast_exp(float x) { return __builtin_amdgcn_exp2f(x * 1.4426950408889634f); }
__device__ __forceinline__ float silu_f(float x) { return x / (1.0f + __expf(-x)); }

#define XB_TMO      128
#define XB_XCNT(j)  (256  + 64 * (j))
#define XB_XSUB(j)  (1280 + 64 * (j))
#define XB_XGEN(j)  (2304 + 64 * (j))
#define XB_TOP      3328
#define XB_TOPGEN   3392
#define XCD_BAR_WORDS 3456
#define XB_SPIN_CAP (1u << 22)
__device__ __forceinline__ unsigned xb_ld(unsigned* p)              { return __hip_atomic_load(p, __ATOMIC_RELAXED, __HIP_MEMORY_SCOPE_AGENT); }
__device__ __forceinline__ unsigned xb_add(unsigned* p, unsigned v) { return __hip_atomic_fetch_add(p, v, __ATOMIC_RELAXED, __HIP_MEMORY_SCOPE_AGENT); }
__device__ __forceinline__ unsigned xb_xcc_id() { return (unsigned)__builtin_amdgcn_s_getreg((3 << 11) | 20) & 0xFu; }
#define XB_SPIN(cond, bar) do { unsigned _sp = 0; while (cond) { __builtin_amdgcn_s_sleep(1); \
    if ((++_sp & 255u) == 0u) { if (xb_ld(&(bar)[XB_TMO])) break; if (_sp > XB_SPIN_CAP) { atomicAdd(&(bar)[XB_TMO], 1u); break; } } } } while (0)
struct XcdBarrier { unsigned* bar; unsigned x; volatile LAS unsigned* st; };
__device__ __forceinline__ XcdBarrier xcd_barrier_post(unsigned* bar, volatile LAS unsigned* st) {
    XcdBarrier b; b.bar = bar; b.x = xb_xcc_id(); b.st = st;
    if (threadIdx.x == 0) (void)xb_add(&bar[XB_XCNT(b.x)], 1u);
    return b;
}
__device__ __forceinline__ void xcd_barrier_complete(unsigned* bar, unsigned x, unsigned& nloc, unsigned& nx) {
    const unsigned G = gridDim.x * gridDim.y * gridDim.z;
    unsigned sum, cnt, mine, sp = 0u;
    for (;;) {
        sum = 0u; cnt = 0u; mine = 0u;
#pragma unroll
        for (unsigned j = 0; j < 16; ++j) { const unsigned c = xb_ld(&bar[XB_XCNT(j)]); sum += c; cnt += (c > 0u) ? 1u : 0u; mine = (j == x) ? c : mine; }
        if (sum == G) break;
        __builtin_amdgcn_s_sleep(1);
        if ((++sp & 255u) == 0u) { if (xb_ld(&bar[XB_TMO])) break; if (sp > XB_SPIN_CAP) { atomicAdd(&bar[XB_TMO], 1u); break; } }
    }
    nloc = mine > 0u ? mine : 1u; nx = cnt > 0u ? cnt : 1u;
}
__device__ __forceinline__ void xcd_barrier(const XcdBarrier& b) {
    asm volatile("s_waitcnt vmcnt(0)" ::: "memory");
    __syncthreads();
    if (threadIdx.x == 0) {
        unsigned* bar = b.bar;
        __builtin_amdgcn_s_waitcnt(0);
        unsigned nloc = b.st[0], nx = b.st[1];
        if (nloc == 0u) { xcd_barrier_complete(bar, b.x, nloc, nx); b.st[0] = nloc; b.st[1] = nx; }
        const unsigned old = xb_add(&bar[XB_XSUB(b.x)], 1u);
        const unsigned gen = old / nloc;
        if (old + 1u == (gen + 1u) * nloc) {
            __builtin_amdgcn_fence(__ATOMIC_RELEASE, "agent");
            asm volatile("s_waitcnt vmcnt(0)" ::: "memory");
            const unsigned og = xb_add(&bar[XB_TOP], 1u);
            const unsigned tg = og / nx;
            if (og + 1u == (tg + 1u) * nx) xb_add(&bar[XB_TOPGEN], 1u);
            else XB_SPIN(xb_ld(&bar[XB_TOPGEN]) == tg, bar);
            __builtin_amdgcn_fence(__ATOMIC_ACQUIRE, "agent");
            xb_add(&bar[XB_XGEN(b.x)], 1u);
            asm volatile("s_waitcnt vmcnt(0)" ::: "memory");
        } else {
            XB_SPIN(xb_ld(&bar[XB_XGEN(b.x)]) == gen, bar);
            __builtin_amdgcn_fence(__ATOMIC_ACQUIRE, "agent");
            asm volatile("s_waitcnt vmcnt(0)" ::: "memory");
        }
    }
    __syncthreads();
}

struct Args { const float* in[28]; float* out; unsigned char* ws; };
struct Frame {
    LAS unsigned char* lds;
    gu32* ctl;
    int tid, lane, wave, G, bid;
    const float* const* ka;
    float* out; unsigned char* ws;
    bf16* big;
    __device__ __forceinline__ const float* inp(int k) const { return ka[k]; }
};
#define PHASE_FENCE() do { int t_ = F.tid; asm volatile("" : "+v"(t_)); F.tid = t_; F.lane = t_ & 63; const float* const* k_ = F.ka; asm volatile("" : "+s"(k_)); F.ka = k_; } while (0)

namespace pg8 {
constexpr int BM = 256, BK = 64, HALF = 128, HTB = HALF * BK * 2, STAGE_BYTES = 8 * HTB, NXCD = 8, WGM = 8;
__host__ __device__ __forceinline__ int lds_byte(int r, int c) { const int st = (r >> 4) * 2 + (c >> 5), rr = r & 15, cc = c & 31, ob = rr * 64 + cc * 2; return st * 1024 + (ob ^ (((ob >> 9) & 1) << 5)); }
__host__ __device__ __forceinline__ void stage_rc(int b, int& R, int& C) { const int st = b / 1024, sb = b % 1024, swz = sb ^ (((sb >> 9) & 1) << 5); R = (st >> 1) * 16 + swz / 64; C = (st & 1) * 32 + (swz % 64) / 2; }
__host__ __device__ __forceinline__ int perm32(int rho) { const int n = rho >> 4, i = rho & 15; return 8 * (i >> 2) + 4 * n + (i & 3); }

struct Unit { int pm, pn, kind; const char* A; const char* B; };
struct TileOrder {
    int nM, nN, nwg, G, c;
    __device__ void init(int nM_, int nN_, int G_, int c_) { nM = nM_; nN = nN_; nwg = nM * nN; G = G_; c = c_; }
    __device__ bool tile(long L, int& pm, int& pn) const {
        if (L >= nwg) return false;
        int wgid = (int)L; { const int q = nwg / NXCD, r = nwg % NXCD, xcd = wgid % NXCD, off = wgid / NXCD; wgid = (xcd < r ? xcd * (q + 1) : r * (q + 1) + (xcd - r) * q) + off; }
        const int nig = WGM * nN, gid = wgid / nig, fm = gid * WGM, gsz = (nM - fm) < WGM ? (nM - fm) : WGM;
        pm = fm + ((wgid % nig) % gsz); pn = (wgid % nig) / gsz; return true;
    }
};

template <class Epi, class Sched>
__device__ __forceinline__ void gemm_phase(LAS unsigned char* lds, const int tid, const int K, const int lda, const Sched& S, const Epi& E) {
    const int wid = __builtin_amdgcn_readfirstlane(tid >> 6), lane = tid & 63, wr = wid >> 2, wc = wid & 3, fr = lane & 15, fq = lane >> 4;
    const int nt = K / BK;
    unsigned voffA[2], voffB[2];
#pragma unroll
    for (int i = 0; i < 2; ++i) { int R, C; stage_rc(tid * 16 + i * 8192, R, C); const int Rb = Epi::PERM ? ((R & ~31) + perm32(R & 31)) : R;
        voffA[i] = (unsigned)(R * lda + C) * 2u; voffB[i] = (unsigned)(Rb * K + C) * 2u; }
    const size_t kstep = (size_t)(BK * 2);
    const size_t hstepA = (size_t)HALF * lda * 2, hstepB = (size_t)HALF * K * 2;
    const unsigned ldsw = (unsigned)wid * 1024u;
    const int aoff = lds_byte(wr * 64 + fr, fq * 8), boff = lds_byte(wc * 32 + fr, fq * 8);
#define PG8_SA(b, h) (((b) * 2 + (h)) * HTB)
#define PG8_SB(b, h) ((4 + (b) * 2 + (h)) * HTB)
#define PG8_STAGE(bufoff, gbase, voff) do { _Pragma("unroll") for (int _i = 0; _i < 2; ++_i) \
        __builtin_amdgcn_global_load_lds((const unsigned*)((const char*)(gbase) + (voff)[_i]), (LAS unsigned*)(lds + (bufoff) + ldsw + _i * 8192), 16, 0, 0); } while (0)
#define PG8_LDA(dst, b, h) do { _Pragma("unroll") for (int m = 0; m < 4; ++m) _Pragma("unroll") for (int k = 0; k < 2; ++k) dst[m][k] = *(const LAS bf16x8*)(lds + PG8_SA(b, h) + aoff + m * 2048 + k * 1024); } while (0)
#define PG8_LDB(dst, b, h) do { _Pragma("unroll") for (int n = 0; n < 2; ++n) _Pragma("unroll") for (int k = 0; k < 2; ++k) dst[n][k] = *(const LAS bf16x8*)(lds + PG8_SB(b, h) + boff + n * 2048 + k * 1024); } while (0)
#define PG8_MMA(ai, bj, At, Bt) do { __builtin_amdgcn_s_setprio(1); _Pragma("unroll") for (int m = 0; m < 4; ++m) _Pragma("unroll") for (int n = 0; n < 2; ++n) _Pragma("unroll") for (int k = 0; k < 2; ++k) \
        acc[ai][bj][m][n] = __builtin_amdgcn_mfma_f32_16x16x32_bf16(Bt[n][k], At[m][k], acc[ai][bj][m][n], 0, 0, 0); __builtin_amdgcn_s_setprio(0); } while (0)
#define PG8_WAIT_V(n) asm volatile("s_waitcnt vmcnt(" #n ")" ::: "memory")
#define PG8_WAIT_L(n) asm volatile("s_waitcnt lgkmcnt(" #n ")" ::: "memory")
#define PG8_BAR __builtin_amdgcn_s_barrier()
#define PG8_SCHED __builtin_amdgcn_sched_barrier(0)
    Unit cur, nxt; int ui = 0;
    if (!S.next(0, cur)) return;
    f32x4 acc[2][2][4][2];
#pragma unroll
    for (int a = 0; a < 2; ++a)
#pragma unroll
        for (int b = 0; b < 2; ++b)
#pragma unroll
            for (int m = 0; m < 4; ++m)
#pragma unroll
                for (int n = 0; n < 2; ++n) acc[a][b][m][n] = (f32x4){0.f, 0.f, 0.f, 0.f};
    bf16x8 At[4][2], B0[2][2], B1[2][2];
    const char* cA = cur.A; const char* cB = cur.B;
    PG8_STAGE(PG8_SB(0, 0), cB, voffB); PG8_STAGE(PG8_SB(0, 1), cB + hstepB, voffB); PG8_STAGE(PG8_SA(0, 0), cA, voffA); PG8_STAGE(PG8_SA(0, 1), cA + hstepA, voffA);
    if (wr == 1) PG8_BAR;
    PG8_WAIT_V(2); PG8_BAR;
    PG8_STAGE(PG8_SB(1, 0), cB + kstep, voffB); PG8_STAGE(PG8_SA(1, 0), cA + kstep, voffA); PG8_STAGE(PG8_SB(1, 1), cB + hstepB + kstep, voffB);
    PG8_WAIT_V(6); PG8_BAR;
    for (;;) {
        const bool has_next = S.next(ui + 1, nxt);
        const char* nA = has_next ? nxt.A : cA; const char* nB = has_next ? nxt.B : cB;
        for (int t = 0; t < nt; t += 2) {
            const bool last = (t == nt - 2);
            const char* a1 = cA + (size_t)(t + 1) * kstep;
            const char* a2 = last ? nA : cA + (size_t)(t + 2) * kstep; const char* b2 = last ? nB : cB + (size_t)(t + 2) * kstep;
            const char* a3 = a2 + kstep; const char* b3 = b2 + kstep;
            PG8_LDB(B0, 0, 0); PG8_LDB(B1, 0, 1); PG8_SCHED; PG8_LDA(At, 0, 0); PG8_STAGE(PG8_SA(1, 1), a1 + hstepA, voffA);
            PG8_WAIT_V(8); PG8_WAIT_L(0); PG8_BAR; PG8_MMA(0, 0, At, B0); PG8_MMA(0, 1, At, B1); PG8_BAR; PG8_SCHED;
            PG8_LDA(At, 0, 1); PG8_STAGE(PG8_SB(0, 0), b2, voffB); PG8_STAGE(PG8_SB(0, 1), b2 + hstepB, voffB); PG8_STAGE(PG8_SA(0, 0), a2, voffA);
            PG8_WAIT_V(8); PG8_WAIT_L(0); PG8_BAR; PG8_MMA(1, 0, At, B0); PG8_MMA(1, 1, At, B1); PG8_BAR; PG8_SCHED;
            PG8_LDB(B0, 1, 0); PG8_LDB(B1, 1, 1); PG8_SCHED; PG8_LDA(At, 1, 0); PG8_STAGE(PG8_SA(0, 1), a2 + hstepA, voffA);
            PG8_WAIT_V(8); PG8_WAIT_L(0); PG8_BAR; PG8_MMA(0, 0, At, B0); PG8_MMA(0, 1, At, B1); PG8_BAR; PG8_SCHED;
            PG8_LDA(At, 1, 1); PG8_STAGE(PG8_SB(1, 0), b3, voffB); PG8_STAGE(PG8_SB(1, 1), b3 + hstepB, voffB); PG8_STAGE(PG8_SA(1, 0), a3, voffA);
            PG8_WAIT_V(8); PG8_WAIT_L(0); PG8_BAR; PG8_MMA(1, 0, At, B0); PG8_MMA(1, 1, At, B1); PG8_BAR; PG8_SCHED;
        }
        if (wr == 0) PG8_BAR;
        E(acc, cur, wr, wc, fr, fq);
        if (!has_next) break;
#pragma unroll
        for (int a = 0; a < 2; ++a)
#pragma unroll
            for (int b = 0; b < 2; ++b)
#pragma unroll
                for (int m = 0; m < 4; ++m)
#pragma unroll
                    for (int n = 0; n < 2; ++n) acc[a][b][m][n] = (f32x4){0.f, 0.f, 0.f, 0.f};
        cur = nxt; cA = nA; cB = nB; ++ui;
        if (wr == 1) PG8_BAR;
    }
    PG8_WAIT_V(0);
    PG8_BAR;
#undef PG8_SA
#undef PG8_SB
#undef PG8_STAGE
#undef PG8_LDA
#undef PG8_LDB
#undef PG8_MMA
#undef PG8_WAIT_V
#undef PG8_WAIT_L
#undef PG8_BAR
#undef PG8_SCHED
}
}

__device__ __forceinline__ void tr_item(const float* W, int ldw, bf16* WT, int K, int k0, int dst_row0, int src_col0, int nvalid, const float* gain, LAS float* scr, int lane) {
    const int n = lane & 31;
#pragma unroll 8
    for (int i = 0; i < 32; ++i) { const int kk = 2 * i + (lane >> 5);
        float v = (n < nvalid) ? W[(size_t)(k0 + kk) * ldw + src_col0 + n] : 0.f;
        if (gain) v *= gain[k0 + kk];
        scr[kk * 33 + n] = v; }
    LDS_WAIT(); asm volatile("" ::: "memory");
    const int c = lane & 7;
#pragma unroll
    for (int j = 0; j < 4; ++j) { const int nn = (lane >> 3) + 8 * j; const LAS float* s = scr + (8 * c) * 33 + nn;
        u32x4 o; o.x = pk2(s[0 * 33], s[1 * 33]); o.y = pk2(s[2 * 33], s[3 * 33]); o.z = pk2(s[4 * 33], s[5 * 33]); o.w = pk2(s[6 * 33], s[7 * 33]);
        *(GAS u32x4*)(WT + (size_t)(dst_row0 + nn) * K + k0 + 8 * c) = o; }
    LDS_WAIT(); asm volatile("" ::: "memory");
}
__device__ __forceinline__ void wt_item(Frame& F, int it, LAS float* scr) {
    const float* W; int ldw, K, nblk, map; bf16* dst; const float* gain;
    int r = it;
    if (r < 2432) { W = F.inp(15); ldw = 4624; K = 1024; nblk = 152; map = 1; dst = (bf16*)(F.ws + WS_WA); gain = F.inp(9); }
    else if ((r -= 2432) < 768) { W = F.inp(20); ldw = 1024; K = 1536; nblk = 32; map = 0; dst = (bf16*)(F.ws + WS_WOA); gain = nullptr; }
    else if ((r -= 768) < 2816) { W = F.inp(26); ldw = 5632; K = 1024; nblk = 176; map = 2; dst = (bf16*)(F.ws + WS_WGU0); gain = F.inp(10); }
    else if ((r -= 2816) < 1408) { W = F.inp(27); ldw = 1024; K = 2816; nblk = 32; map = 0; dst = (bf16*)(F.ws + WS_WD0); gain = nullptr; }
    else if ((r -= 1408) < 1024) { W = F.inp(21); ldw = 2048; K = 1024; nblk = 64; map = 3; dst = (bf16*)(F.ws + WS_WB); gain = F.inp(9) + 1024; }
    else if ((r -= 1024) < 768) { W = F.inp(25); ldw = 1024; K = 1536; nblk = 32; map = 0; dst = (bf16*)(F.ws + WS_WOB); gain = nullptr; }
    else if ((r -= 768) < 2816) { W = F.inp(26) + (size_t)1024 * 5632; ldw = 5632; K = 1024; nblk = 176; map = 2; dst = (bf16*)(F.ws + WS_WGU1); gain = F.inp(10) + 1024; }
    else if ((r -= 2816) < 1408) { W = F.inp(27) + (size_t)2816 * 1024; ldw = 1024; K = 2816; nblk = 32; map = 0; dst = (bf16*)(F.ws + WS_WD1); gain = nullptr; }
    else if ((r -= 1408) < 512) { W = F.inp(12); ldw = 1024; K = 1024; nblk = 32; map = 0; dst = (bf16*)(F.ws + WS_WMEM); gain = F.inp(11); }
    else { r -= 512; W = F.inp(12) + (size_t)1024 * 1024; ldw = 1024; K = 1024; nblk = 32; map = 0; dst = (bf16*)(F.ws + WS_WMEM) + (size_t)1024 * 1024; gain = F.inp(11) + 1024; }
    const int kb = r / nblk, nb = r % nblk;
    int src0 = 32 * nb, nv = 32;
    if (map == 1) { if (nb < 128) { src0 = 32 * nb; } else if (nb < 144) { src0 = 4112 + 32 * (nb - 128); } else if (nb == 144) { src0 = 4096; nv = 16; } else { src0 = 0; nv = 0; } }
    else if (map == 2) { const int pn = nb >> 3, w = nb & 7; src0 = (w < 4) ? (128 * pn + 32 * w) : (2816 + 128 * pn + 32 * (w - 4)); }
    else if (map == 3) { if (nb < 32) src0 = 32 * nb; else if (nb < 48) src0 = 1536 + 32 * (nb - 32); else src0 = 1024 + 32 * (nb - 48); }
    tr_item(W, ldw, dst, K, 64 * kb, 32 * nb, src0, nv, gain, scr, F.lane);
}
constexpr int N_WT_ITEMS = 14464;
__device__ __forceinline__ void row_to_bf16(const float* xrow, bf16* orow, float* ss, int lane) {
    const GAS f32x4* xr = (const GAS f32x4*)xrow + lane;
    f32x4 v[4]; float s = 0.f;
#pragma unroll
    for (int j = 0; j < 4; ++j) { v[j] = xr[64 * j]; s += (v[j].x * v[j].x + v[j].y * v[j].y) + (v[j].z * v[j].z + v[j].w * v[j].w); }
    s = wave_sum(s);
    GAS u32x2* o8 = (GAS u32x2*)orow + lane;
#pragma unroll
    for (int j = 0; j < 4; ++j) { u32x2 w; w.x = pk2(v[j].x, v[j].y); w.y = pk2(v[j].z, v[j].w); o8[64 * j] = w; }
    if (lane == 0) *ss = s;
}
__device__ __forceinline__ void p0_prologue(Frame& F) {
    LAS float* scr = (LAS float*)(F.lds + F.wave * 16384);
    const int gw = F.bid * 8 + F.wave, NGW = F.G * 8;
    for (int it = gw; it < N_WT_ITEMS; it += NGW) wt_item(F, it, scr);
    bf16* xb = (bf16*)F.out;
    float* rss0 = (float*)(F.ws + WS_ROWSS0);
    for (int m = gw; m < NTOK + 256; m += NGW) {
        if (m < SEQ) row_to_bf16(F.inp(0) + (size_t)m * D, xb + (size_t)m * D, rss0 + m, F.lane);
        else if (m < NTOK) row_to_bf16(F.inp(1) + (size_t)(m - SEQ) * D, xb + (size_t)m * D, rss0 + m, F.lane);
        else row_to_bf16(F.inp(2) + (size_t)(m - NTOK) * D, (bf16*)(F.ws + WS_MEMB) + (size_t)(m - NTOK) * D, rss0 + m, F.lane);
    }
}

struct SchedP1 {
    pg8::TileOrder T; const char* A; const char* B; const char* Amem; const char* Bmem;
    __device__ bool next(int i, pg8::Unit& u) const {
        const long L = (long)i * T.G + T.c;
        if (L < T.nwg) { T.tile(L, u.pm, u.pn); u.kind = 0; u.A = A + (size_t)u.pm * 256 * 1024 * 2; u.B = B + (size_t)u.pn * 256 * 1024 * 2; return true; }
        const int e = (int)(L - T.nwg); if (e >= 8) return false;
        u.pm = 0; u.pn = e; u.kind = 1; u.A = Amem; u.B = Bmem + (size_t)e * 256 * 1024 * 2; return true;
    }
};
struct EpiP1 {
    static constexpr bool PERM = true;
    bf16* big; bf16* halo; float* ba; const float* rss0; float* kvraw; float* out;
    __device__ __forceinline__ void operator()(const f32x4 (&acc)[2][2][4][2], const pg8::Unit& u, int wr, int wc, int fr, int fq) const {
        asm volatile("" : "+v"(fr), "+v"(fq));
        if (u.kind == 0) {
            const int row0 = u.pm * 256 + wr * 64 + fr, colb = u.pn * 256 + wc * 32 + 8 * fq;
#pragma unroll
            for (int ai = 0; ai < 2; ++ai)
#pragma unroll
                for (int m = 0; m < 4; ++m) {
                    const int row = row0 + ai * 128 + m * 16;
                    const float inv = 1.0f / sqrtf(rss0[row] * (1.0f / 1024.0f) + EPS);
#pragma unroll
                    for (int bj = 0; bj < 2; ++bj) {
                        const f32x4 v0 = acc[ai][bj][m][0] * inv, v1 = acc[ai][bj][m][1] * inv; const int col = colb + bj * 128;
                        if (u.pn < 18) {
                            u32x4 w; w.x = pk2(v0[0], v0[1]); w.y = pk2(v0[2], v0[3]); w.z = pk2(v1[0], v1[1]); w.w = pk2(v1[2], v1[3]);
                            *(u32x4*)(big + (size_t)row * PITCH + col) = w;
                            if (m == 3 && fr >= 13 && u.pn < 12) {
                                const int cid = row >> 6, j = fr - 13;
                                *(u32x4*)(halo + ((size_t)cid * 3 + j) * 3072 + col) = w;
                                if (cid >= 255) { float* o = (cid == 255) ? out + O_CONV_P + (size_t)j * 3072 + col : out + O_CONV_S + ((size_t)(cid - 256) * 3 + j) * 3072 + col;
                                    *(f32x4*)o = v0; *(f32x4*)(o + 4) = v1; }
                            }
                        } else if (bj == 0 && wc == 0 && fq < 2) {
                            float* o = ba + (size_t)row * 16 + 8 * fq; *(f32x4*)o = v0; *(f32x4*)(o + 4) = v1;
                        }
                    }
                }
        } else {
            const int layer = u.pn >> 2, pnn = u.pn & 3;
            const int row0 = wr * 64 + fr, colb = pnn * 256 + wc * 32 + 8 * fq;
#pragma unroll
            for (int ai = 0; ai < 2; ++ai)
#pragma unroll
                for (int m = 0; m < 4; ++m) {
                    const int row = row0 + ai * 128 + m * 16;
                    const float inv = 1.0f / sqrtf(rss0[NTOK + row] * (1.0f / 1024.0f) + EPS);
#pragma unroll
                    for (int bj = 0; bj < 2; ++bj) {
                        float* o = kvraw + ((size_t)layer * 256 + row) * 1024 + colb + bj * 128;
                        *(f32x4*)o = acc[ai][bj][m][0] * inv; *(f32x4*)(o + 4) = acc[ai][bj][m][1] * inv;
                    }
                }
        }
    }
};

__device__ __forceinline__ bf16* kimg_ptr(unsigned char* ws, int layer, int stream, int head) { return (bf16*)(ws + WS_KVIMG) + ((size_t)((layer * 9 + stream) * 4 + head)) * 65536; }
__device__ __forceinline__ bf16* vtimg_ptr(unsigned char* ws, int layer, int stream, int head) { return kimg_ptr(ws, layer, stream, head) + 32768; }
__device__ __forceinline__ void fix_items(Frame& F, int gw, int NGW) {
    const int lane = F.lane;
    for (int it = gw; it < 512; it += NGW) {
        const int layer = it >> 8, m = it & 255;
        const float* src = (const float*)(F.ws + WS_KVRAW) + ((size_t)layer * 256 + m) * 1024 + 16 * lane;
        f32x4 v[4];
#pragma unroll
        for (int j = 0; j < 4; ++j) v[j] = *(const f32x4*)(src + 4 * j);
        const int col = 16 * lane;
        if (col < 512) {
            float s = 0.f;
#pragma unroll
            for (int j = 0; j < 4; ++j) s += (v[j].x * v[j].x + v[j].y * v[j].y) + (v[j].z * v[j].z + v[j].w * v[j].w);
            s += __shfl_xor(s, 1); s += __shfl_xor(s, 2); s += __shfl_xor(s, 4);
            const float inv = 1.0f / sqrtf(s * (1.0f / 128.0f) + EPS);
            const int hd = col >> 7, d0 = col & 127;
            const float* kg = F.inp(14) + layer * 128 + d0; const float* qg = F.inp(13) + layer * 128 + d0;
            float* o = F.out + O_MEMK + ((size_t)layer * 256 + m) * 512 + col;
            bf16* ki = kimg_ptr(F.ws, layer, 0, hd) + (size_t)m * 128 + d0;
            unsigned pw[8];
#pragma unroll
            for (int j = 0; j < 4; ++j) { f32x4 g = *(const f32x4*)(kg + 4 * j), q = *(const f32x4*)(qg + 4 * j); f32x4 r = v[j] * inv * g; *(f32x4*)(o + 4 * j) = r; r = r * q; pw[2 * j] = pk2(r.x, r.y); pw[2 * j + 1] = pk2(r.z, r.w); }
            *(u32x4*)ki = (u32x4){pw[0], pw[1], pw[2], pw[3]}; *(u32x4*)(ki + 8) = (u32x4){pw[4], pw[5], pw[6], pw[7]};
        } else {
            const int c2 = col - 512, hd = c2 >> 7, d0 = c2 & 127;
            float* o = F.out + O_MEMV + ((size_t)layer * 256 + m) * 512 + c2;
            bf16* vt = vtimg_ptr(F.ws, layer, 0, hd);
#pragma unroll
            for (int j = 0; j < 4; ++j) { *(f32x4*)(o + 4 * j) = v[j];
#pragma unroll
                for (int e = 0; e < 4; ++e) vt[(size_t)(d0 + 4 * j + e) * 256 + m] = (bf16)(pk2(v[j][e], 0.f) & 0xffffu); }
        }
    }
    for (int it = gw; it < 4096; it += NGW) {
        const int layer = it >> 11, b = (it >> 8) & 7, m = it & 255;
        const size_t base = (((size_t)layer * 8 + b) * 256 + m) * 512 + 8 * lane;
        const int hd = (8 * lane) >> 7, d0 = (8 * lane) & 127;
        const f32x4 k0 = *(const f32x4*)(F.inp(3) + base), k1 = *(const f32x4*)(F.inp(3) + base + 4);
        const f32x4 v0 = *(const f32x4*)(F.inp(4) + base), v1 = *(const f32x4*)(F.inp(4) + base + 4);
        const float* qg = F.inp(13) + layer * 128 + d0; const f32x4 q0 = *(const f32x4*)qg, q1 = *(const f32x4*)(qg + 4);
        const f32x4 a = k0 * q0, c = k1 * q1;
        *(u32x4*)(kimg_ptr(F.ws, layer, 1 + b, hd) + (size_t)m * 128 + d0) = (u32x4){pk2(a.x, a.y), pk2(a.z, a.w), pk2(c.x, c.y), pk2(c.z, c.w)};
        bf16* vt = vtimg_ptr(F.ws, layer, 1 + b, hd);
#pragma unroll
        for (int e = 0; e < 4; ++e) { vt[(size_t)(d0 + e) * 256 + m] = (bf16)(pk2(v0[e], 0.f) & 0xffffu); vt[(size_t)(d0 + 4 + e) * 256 + m] = (bf16)(pk2(v1[e], 0.f) & 0xffffu); }
    }
    for (int it = gw; it < 1024; it += NGW) {
        const size_t base = (size_t)it * 256 + 4 * lane; const int d0 = (4 * lane) & 63;
        const f32x4 k = *(const f32x4*)(F.inp(7) + base), v = *(const f32x4*)(F.inp(8) + base), q = *(const f32x4*)(F.inp(22) + d0);
        const f32x4 a = k * q;
        bf16* ko = (bf16*)(F.ws + WS_SWAC) + base; bf16* vo = ko + 8 * 128 * 256;
        *(u32x2*)ko = (u32x2){pk2(a.x, a.y), pk2(a.z, a.w)}; *(u32x2*)vo = (u32x2){pk2(v.x, v.y), pk2(v.z, v.w)};
    }
}

constexpr int PREP_HALF = 71680;
constexpr int PR_KT = 0, PR_QT = 17408, PR_VB = 34816, PR_AM = 52224  , PR_BETA = 70464, PR_CUM = 70720, PR_GSC = 70976, PR_G = 71232;
static_assert(2 * PREP_HALF <= MISC_OFF && PR_AM + 18224 <= PR_BETA, "prep LDS");
__device__ __forceinline__ void conv8(const LAS bf16* rawp, const float* wp, float (&o)[8]) {
#pragma unroll
    for (int e = 0; e < 8; ++e) o[e] = 0.f;
#pragma unroll
    for (int tap = 0; tap < 4; ++tap) {
        const u32x4 r = *(const LAS u32x4*)(rawp + tap * 136);
        const f32x4 w0 = *(const f32x4*)(wp + tap * 3072), w1 = *(const f32x4*)(wp + tap * 3072 + 4);
        o[0] += bflo(r.x) * w0.x; o[1] += bfhi(r.x) * w0.y; o[2] += bflo(r.y) * w0.z; o[3] += bfhi(r.y) * w0.w;
        o[4] += bflo(r.z) * w1.x; o[5] += bfhi(r.z) * w1.y; o[6] += bflo(r.w) * w1.z; o[7] += bfhi(r.w) * w1.w;
    }
#pragma unroll
    for (int e = 0; e < 8; ++e) o[e] = silu_f(o[e]);
}
__device__ __forceinline__ int crow32(int g, int hh) { return (g & 3) + 8 * (g >> 2) + 4 * hh; }
__device__ __forceinline__ bf16 f2b(float v) { return (bf16)(pk2(v, 0.f) & 0xffffu); }
__device__ __forceinline__ void prep_unit(Frame& F, int cid, int hp) {
    const int hw = F.wave >> 2, h = 2 * hp + hw, th = F.tid & 255, wv = F.wave & 3, lane = F.lane;
    LAS unsigned char* L = F.lds + hw * PREP_HALF;
    LAS bf16* raw = (LAS bf16*)(L + PR_AM);
    LAS bf16* kt = (LAS bf16*)(L + PR_KT); LAS bf16* qt = (LAS bf16*)(L + PR_QT); LAS bf16* vb = (LAS bf16*)(L + PR_VB);
    LAS float* Am = (LAS float*)(L + PR_AM);
    LAS float* beta = (LAS float*)(L + PR_BETA); LAS float* cum = (LAS float*)(L + PR_CUM); LAS float* gsc = (LAS float*)(L + PR_GSC); LAS float* gtmp = (LAS float*)(L + PR_G);
    bf16* bigrow = F.big + (size_t)cid * 64 * PITCH;
    if (th < 64) {
        const float* bap = (const float*)(F.ws + WS_BA) + ((size_t)cid * 64 + th) * 16;
        const float braw = bap[h], araw = bap[8 + h];
        const float x = araw + F.inp(18)[h];
        const float sp = (x > 20.f) ? x : log1pf(__expf(x));
        gtmp[th] = -__expf(F.inp(17)[h]) * sp;
        beta[th] = 1.0f / (1.0f + __expf(-braw));
    }
    __syncthreads();
    if (th < 64) { float c = 0.f; for (int j = 0; j <= th; ++j) c += gtmp[j]; cum[th] = c; gsc[th] = beta[th] * __expf(c); }
    const int i = th >> 2, seg = th & 3;
#pragma unroll 1
    for (int part = 0; part < 3; ++part) {
        const int colg = part * 1024 + 128 * h;
        for (int p = th; p < 1072; p += 256) {
            const int j = p >> 4, c16 = p & 15; const int col = colg + 8 * c16;
            u32x4 v;
            if (j >= 3) v = *(const u32x4*)(bigrow + (unsigned)((j - 3) * PITCH + col));
            else if (cid == 0) v = (u32x4){0u, 0u, 0u, 0u};
            else if (cid < 256) v = *(const u32x4*)((const bf16*)(F.ws + WS_HALO) + ((size_t)(cid - 1) * 3 + j) * 3072 + col);
            else { const float* sp = F.inp(6) + ((size_t)(cid - 256) * 3 + j) * 3072 + col; const f32x4 a = *(const f32x4*)sp, b = *(const f32x4*)(sp + 4);
                   v = (u32x4){pk2(a.x, a.y), pk2(a.z, a.w), pk2(b.x, b.y), pk2(b.z, b.w)}; }
            *(LAS u32x4*)(raw + j * 136 + 8 * c16) = v;
        }
        __syncthreads();
        float xv[32];
        const float* cw = F.inp(16) + colg + seg * 32;
#pragma unroll
        for (int g8 = 0; g8 < 4; ++g8) {
            float o[8];
            conv8(raw + i * 136 + seg * 32 + g8 * 8, cw + g8 * 8, o);
#pragma unroll
            for (int e = 0; e < 8; ++e) xv[g8 * 8 + e] = o[e];
            asm volatile("" ::: "memory");
        }
        float sc;
        if (part < 2) {
            float ss = 0.f;
#pragma unroll
            for (int e = 0; e < 32; ++e) ss += xv[e] * xv[e];
            ss += __shfl_xor(ss, 1); ss += __shfl_xor(ss, 2);
            sc = 1.0f / sqrtf(ss + EPS); if (part == 0) sc *= 0.08838834764831845f;
        } else sc = beta[i];
        LAS bf16* dst = (part == 0 ? qt : (part == 1 ? kt : vb)) + i * 136 + seg * 32;
#pragma unroll
        for (int g8 = 0; g8 < 4; ++g8)
            *(LAS u32x4*)(dst + g8 * 8) = (u32x4){pk2(xv[g8*8+0] * sc, xv[g8*8+1] * sc), pk2(xv[g8*8+2] * sc, xv[g8*8+3] * sc), pk2(xv[g8*8+4] * sc, xv[g8*8+5] * sc), pk2(xv[g8*8+6] * sc, xv[g8*8+7] * sc)};
        __syncthreads();
    }
    bf16* qx = (bf16*)F.out + (size_t)(cid * 8 + h) * 12288;
    {
        const int ti = wv >> 1, tj = wv & 1, r = lane & 31, hh = lane >> 5;
        f32x16 kk, qk;
#pragma unroll
        for (int g = 0; g < 16; ++g) { kk[g] = 0.f; qk[g] = 0.f; }
#pragma unroll
        for (int s = 0; s < 8; ++s) {
            const bf16x8 a = *(const LAS bf16x8*)(kt + (32 * ti + r) * 136 + 16 * s + 8 * hh);
            const bf16x8 q = *(const LAS bf16x8*)(qt + (32 * ti + r) * 136 + 16 * s + 8 * hh);
            const bf16x8 b = *(const LAS bf16x8*)(kt + (32 * tj + r) * 136 + 16 * s + 8 * hh);
            kk = __builtin_amdgcn_mfma_f32_32x32x16_bf16(a, b, kk, 0, 0, 0);
            qk = __builtin_amdgcn_mfma_f32_32x32x16_bf16(q, b, qk, 0, 0, 0);
        }
        const int j = 32 * tj + r; const float cj = cum[j];
#pragma unroll
        for (int g = 0; g < 16; ++g) {
            int hh_ = hh; asm volatile("" : "+v"(hh_));
            const int ii = 32 * ti + crow32(g, hh_);
            const float dec = __expf(fminf(cum[ii] - cj, 0.f));
            Am[ii * 68 + j] = (ii > j) ? beta[ii] * kk[g] * dec : 0.f;
            const float qm = (ii >= j) ? qk[g] * dec : 0.f;
            qx[(unsigned)(8192 + ii * 64 + (((j >> 3) ^ ((ii >> 1) & 7)) << 3) + (j & 7))] = f2b(qm);
            asm volatile("" ::: "memory");
        }
    }
    __syncthreads();
    {
        const int c = th;
        float sol[64];
        const LAS bf16* rp = (c < 128) ? (vb + c) : (kt + (c - 128));
        const int w = c >> 4, col = c & 15, kk = c - 128;
        bf16* vbase = bigrow + 2048 + 128 * h; bf16* wbase = bigrow + 128 * h;
#pragma unroll
        for (int ii = 0; ii < 64; ++ii) {
            float v = bf2f(rp[ii * 136]); if (c >= 128) v *= gsc[ii];
            int kk_ = kk, col_ = col; asm volatile("" : "+v"(kk_), "+v"(col_));
#pragma unroll
            for (int j4 = 0; j4 < (ii + 3) / 4; ++j4) {
                const f32x4 a = *(const LAS f32x4*)(Am + ii * 68 + 4 * j4);
                v -= a.x * sol[4 * j4];
                if (4 * j4 + 1 < ii) v -= a.y * sol[4 * j4 + 1];
                if (4 * j4 + 2 < ii) v -= a.z * sol[4 * j4 + 2];
                if (4 * j4 + 3 < ii) v -= a.w * sol[4 * j4 + 3];
            }
            sol[ii] = v;
            if (c >= 128) wbase[(unsigned)(ii * PITCH + ((((kk_ >> 3) ^ (ii & 15)) << 3) + (kk_ & 7)))] = f2b(v);
            else if ((ii & 3) == 3) {
                const int t4 = ii >> 4, q = (ii >> 2) & 3; const int e = (((w * 4 + t4) * 4 + q) * 16 + col_) * 4;
                *(u32x2*)(vbase + (unsigned)((e >> 7) * PITCH + (e & 127))) = (u32x2){pk2(sol[ii - 3], sol[ii - 2]), pk2(sol[ii - 1], sol[ii])};
            }
            asm volatile("" ::: "memory");
        }
    }
    {
        const float clast = cum[63];
        bf16* kbase = bigrow + 1024 + 128 * h;
#pragma unroll 1
        for (int pp = 0; pp < 4; ++pp) {
            const int p = th + 256 * pp, kk = p >> 3, c16 = p & 7;
            float v[8];
#pragma unroll
            for (int e = 0; e < 8; ++e) { const int ii = 8 * c16 + e; v[e] = bf2f(kt[ii * 136 + kk]) * __expf(clast - cum[ii]); }
            const int e0 = kk * 64 + ((c16 ^ ((kk >> 1) & 7)) << 3);
            *(u32x4*)(kbase + (unsigned)((e0 >> 7) * PITCH + (e0 & 127))) = (u32x4){pk2(v[0], v[1]), pk2(v[2], v[3]), pk2(v[4], v[5]), pk2(v[6], v[7])};
        }
#pragma unroll 1
        for (int pp = 0; pp < 4; ++pp) {
            const int p = th + 256 * pp, ii = p >> 4, c16 = p & 15;
            const u32x4 r = *(const LAS u32x4*)(qt + ii * 136 + 8 * c16); const float ec = __expf(cum[ii]);
            *(u32x4*)(qx + (unsigned)(ii * 128 + ((c16 ^ (ii & 15)) << 3))) = (u32x4){pk2(bflo(r.x) * ec, bfhi(r.x) * ec), pk2(bflo(r.y) * ec, bfhi(r.y) * ec), pk2(bflo(r.z) * ec, bfhi(r.z) * ec), pk2(bflo(r.w) * ec, bfhi(r.w) * ec)};
        }
        if (th == 0) ((float*)(F.ws + WS_ACHUNK))[cid * 8 + h] = __expf(clast);
    }
    __syncthreads();
}

constexpr int EN_STAGE = 57344, EN_W = 0, EN_KDT = 16384, EN_QD = 32768, EN_QK = 49152, EN_SSQ = 2 * EN_STAGE;
__device__ __forceinline__ void en_stage(Frame& F, int cid, int h, int st) {
    const bf16* big = F.big; const int lane = F.lane;
#pragma unroll
    for (int k = 0; k < 7; ++k) {
        const int piece = F.wave + 8 * k;
        const char* g;
        if (piece < 32) { const int o = (piece & 15) * 1024 + lane * 16; g = (const char*)(big + ((size_t)cid * 64 + (o >> 8)) * PITCH + (piece < 16 ? 0 : 1024) + 128 * h) + (o & 255); }
        else g = (const char*)((const bf16*)F.out + (size_t)(cid * 8 + h) * 12288) + (piece - 32) * 1024 + lane * 16;
        __builtin_amdgcn_global_load_lds((const unsigned*)g, (LAS unsigned*)(F.lds + st * EN_STAGE + piece * 1024), 16, 0, 0);
    }
}
__device__ __forceinline__ bf16x8 pack2(const f32x4& a, const f32x4& b) { u32x4 p = {pk2(a.x, a.y), pk2(a.z, a.w), pk2(b.x, b.y), pk2(b.z, b.w)}; return __builtin_bit_cast(bf16x8, p); }
__device__ __forceinline__ bf16x8 ld_frag(const LAS unsigned char* p0, const LAS unsigned char* p1) { const u32x2 a = *(const LAS u32x2*)p0, b = *(const LAS u32x2*)p1; u32x4 p = {a.x, a.y, b.x, b.y}; return __builtin_bit_cast(bf16x8, p); }
#define MFMA16(a, b, c) __builtin_amdgcn_mfma_f32_16x16x32_bf16((a), (b), (c), 0, 0, 0)
__device__ __forceinline__ void gdn_scan(Frame& F, int cid0, int n, int h, const float* hinit, float* hfinal) {
    const int w = F.wave, lane = F.lane, col = lane & 15, q = lane >> 4;
    bf16* big = F.big;
    LAS float* ssq = (LAS float*)(F.lds + EN_SSQ);
    f32x4 hS[8];
#pragma unroll
    for (int t = 0; t < 8; ++t) {
        if (hinit) { const float* p = hinit + (size_t)(16 * t + 4 * q) * 128 + 16 * w + col; hS[t] = (f32x4){p[0], p[128], p[256], p[384]}; }
        else hS[t] = (f32x4){0.f, 0.f, 0.f, 0.f};
    }
    if (F.tid < 128) ssq[F.tid] = 0.f;
    const float og = F.inp(19)[16 * w + col];
    u32x2 un[4];
    en_stage(F, cid0, h, 0);
#pragma unroll
    for (int t4 = 0; t4 < 4; ++t4) { const int e = (((w * 4 + t4) * 4 + q) * 16 + col) * 4; un[t4] = *(const u32x2*)(big + ((size_t)cid0 * 64 + (e >> 7)) * PITCH + 2048 + 128 * h + (e & 127)); }
    for (int s = 0; s < n; ++s) {
        const int cid = cid0 + s, st = s & 1;
        VM_WAIT(); __syncthreads();
        f32x4 u[4];
#pragma unroll
        for (int t4 = 0; t4 < 4; ++t4) u[t4] = (f32x4){bflo(un[t4].x), bfhi(un[t4].x), bflo(un[t4].y), bfhi(un[t4].y)};
        if (s + 1 < n) {
            en_stage(F, cid + 1, h, st ^ 1);
#pragma unroll
            for (int t4 = 0; t4 < 4; ++t4) { const int e = (((w * 4 + t4) * 4 + q) * 16 + col) * 4; un[t4] = *(const u32x2*)(big + ((size_t)(cid + 1) * 64 + (e >> 7)) * PITCH + 2048 + 128 * h + (e & 127)); }
        }
        if (F.tid < 64) ssq[(st ^ 1) * 64 + F.tid] = 0.f;
        const LAS unsigned char* SB = F.lds + st * EN_STAGE;
        const float ach = ((const float*)(F.ws + WS_ACHUNK))[cid * 8 + h];
        bf16x8 hB[4];
#pragma unroll
        for (int ks = 0; ks < 4; ++ks) hB[ks] = pack2(hS[2 * ks], hS[2 * ks + 1]);
        f32x4 vn[4], o[4];
#pragma unroll
        for (int t4 = 0; t4 < 4; ++t4) {
            const int row = 16 * t4 + col; f32x4 a = {0.f, 0.f, 0.f, 0.f}, b = {0.f, 0.f, 0.f, 0.f};
#pragma unroll
            for (int ks = 0; ks < 4; ++ks) {
                const int c16 = 4 * ks + (q >> 1), off0 = row * 256 + (((c16 ^ (row & 15)) << 3) + (q & 1) * 4) * 2, off1 = row * 256 + ((((c16 + 2) ^ (row & 15)) << 3) + (q & 1) * 4) * 2;
                a = MFMA16(ld_frag(SB + EN_W + off0, SB + EN_W + off1), hB[ks], a);
                b = MFMA16(ld_frag(SB + EN_QD + off0, SB + EN_QD + off1), hB[ks], b);
            }
            vn[t4] = u[t4] - a; o[t4] = b;
        }
        bf16x8 vB[2];
        vB[0] = pack2(vn[0], vn[1]); vB[1] = pack2(vn[2], vn[3]);
#pragma unroll
        for (int t4 = 0; t4 < 4; ++t4) {
            const int row = 16 * t4 + col;
#pragma unroll
            for (int cs = 0; cs < 2; ++cs) {
                if (32 * cs > 16 * t4 + 15) continue;
                const int c16 = 4 * cs + (q >> 1), sw = (row >> 1) & 7, off0 = row * 128 + (((c16 ^ sw) << 3) + (q & 1) * 4) * 2, off1 = row * 128 + ((((c16 + 2) ^ sw) << 3) + (q & 1) * 4) * 2;
                o[t4] = MFMA16(ld_frag(SB + EN_QK + off0, SB + EN_QK + off1), vB[cs], o[t4]);
            }
        }
#pragma unroll
        for (int t = 0; t < 8; ++t) {
            const int row = 16 * t + col; f32x4 a = hS[t] * ach;
#pragma unroll
            for (int cs = 0; cs < 2; ++cs) {
                const int c16 = 4 * cs + (q >> 1), sw = (row >> 1) & 7, off0 = row * 128 + (((c16 ^ sw) << 3) + (q & 1) * 4) * 2, off1 = row * 128 + ((((c16 + 2) ^ sw) << 3) + (q & 1) * 4) * 2;
                a = MFMA16(ld_frag(SB + EN_KDT + off0, SB + EN_KDT + off1), vB[cs], a);
            }
            hS[t] = a;
        }
#pragma unroll
        for (int t4 = 0; t4 < 4; ++t4)
#pragma unroll
            for (int r = 0; r < 4; ++r) {
                float v = o[t4][r] * o[t4][r];
                v += __shfl_xor(v, 1); v += __shfl_xor(v, 2); v += __shfl_xor(v, 4); v += __shfl_xor(v, 8);
                if (col == 0) atomicAdd((float*)(ssq + st * 64 + 16 * t4 + 4 * q + r), v);
            }
        __syncthreads();
#pragma unroll
        for (int t4 = 0; t4 < 4; ++t4)
#pragma unroll
            for (int r = 0; r < 4; ++r) {
                const int row = 16 * t4 + 4 * q + r;
                const float inv = 1.0f / sqrtf(ssq[st * 64 + row] * (1.0f / 128.0f) + EPS);
                bf16* zp = big + ((size_t)cid * 64 + row) * PITCH + C_Z + 128 * h + 16 * w + col;
                const float z = bf2f(*zp);
                *zp = (bf16)(pk2(o[t4][r] * inv * og * silu_f(z), 0.f) & 0xffffu);
            }
    }
    if (hfinal) {
#pragma unroll
        for (int t = 0; t < 8; ++t) { float* p = hfinal + (size_t)(16 * t + 4 * q) * 128 + 16 * w + col; p[0] = hS[t].x; p[128] = hS[t].y; p[256] = hS[t].z; p[384] = hS[t].w; }
    }
    __syncthreads();
}

#define MFMA32(a, b, c) __builtin_amdgcn_mfma_f32_32x32x16_bf16((a), (b), (c), 0, 0, 0)
template <int HD, int NKT, int KP, int VP>
__device__ __forceinline__ void attn_core(const LAS bf16* Ks, const LAS bf16* Vs, bf16* qrow, float scale, float sink, bool has_sink, int lo, int lane) {
    const int r = lane & 31, hh = lane >> 5;
    constexpr int NS = HD / 16, NDT = HD / 32;
    bf16x8 qf[NS]; float ss = 0.f;
#pragma unroll
    for (int s = 0; s < NS; ++s) {
        const u32x4 v = *(const u32x4*)(qrow + 16 * s + 8 * hh); qf[s] = __builtin_bit_cast(bf16x8, v);
        ss += bflo(v.x) * bflo(v.x) + bfhi(v.x) * bfhi(v.x) + bflo(v.y) * bflo(v.y) + bfhi(v.y) * bfhi(v.y) + bflo(v.z) * bflo(v.z) + bfhi(v.z) * bfhi(v.z) + bflo(v.w) * bflo(v.w) + bfhi(v.w) * bfhi(v.w);
    }
    ss += __shfl_xor(ss, 32);
    const float inv = (1.0f / sqrtf(ss * (1.0f / HD) + EPS)) * scale;
    float m = -INFINITY;
#pragma unroll 1
    for (int kt = 0; kt < NKT; ++kt) {
        f32x16 acc;
#pragma unroll
        for (int g = 0; g < 16; ++g) acc[g] = 0.f;
#pragma unroll
        for (int s = 0; s < NS; ++s) acc = MFMA32(*(const LAS bf16x8*)(Ks + (32 * kt + r) * KP + 16 * s + 8 * hh), qf[s], acc);
#pragma unroll
        for (int g = 0; g < 16; ++g) { const int key = 32 * kt + crow32(g, hh); float v = acc[g] * inv; if (key < lo) v = -INFINITY; m = fmaxf(m, v); }
    }
    m = fmaxf(m, __shfl_xor(m, 32)); if (has_sink) m = fmaxf(m, sink);
    float l = 0.f;
    f32x16 O[NDT];
#pragma unroll
    for (int dt = 0; dt < NDT; ++dt)
#pragma unroll
        for (int g = 0; g < 16; ++g) O[dt][g] = 0.f;
#pragma unroll 1
    for (int kt = 0; kt < NKT; ++kt) {
        f32x16 acc;
#pragma unroll
        for (int g = 0; g < 16; ++g) acc[g] = 0.f;
#pragma unroll
        for (int s = 0; s < NS; ++s) acc = MFMA32(*(const LAS bf16x8*)(Ks + (32 * kt + r) * KP + 16 * s + 8 * hh), qf[s], acc);
#pragma unroll
        for (int g = 0; g < 16; ++g) { const int key = 32 * kt + crow32(g, hh); float v = acc[g] * inv; if (key < lo) v = -INFINITY; const float pe = __expf(v - m); acc[g] = pe; l += pe; }
#pragma unroll
        for (int st = 0; st < 2; ++st) {
            const u32x4 pw = {pk2(acc[8 * st], acc[8 * st + 1]), pk2(acc[8 * st + 2], acc[8 * st + 3]), pk2(acc[8 * st + 4], acc[8 * st + 5]), pk2(acc[8 * st + 6], acc[8 * st + 7])};
            const bf16x8 pf = __builtin_bit_cast(bf16x8, pw);
#pragma unroll
            for (int dt = 0; dt < NDT; ++dt) {
                const LAS bf16* vp = Vs + (32 * dt + r) * VP + 32 * kt + 16 * st + 4 * hh;
                O[dt] = MFMA32(ld_frag((const LAS unsigned char*)vp, (const LAS unsigned char*)(vp + 8)), pf, O[dt]);
            }
        }
    }
    l += __shfl_xor(l, 32); if (has_sink) l += __expf(sink - m);
    const float rl = 1.0f / l;
#pragma unroll
    for (int dt = 0; dt < NDT; ++dt)
#pragma unroll
        for (int a4 = 0; a4 < 4; ++a4)
            *(u32x2*)(qrow + 32 * dt + 8 * a4 + 4 * hh) = (u32x2){pk2(O[dt][4 * a4] * rl, O[dt][4 * a4 + 1] * rl), pk2(O[dt][4 * a4 + 2] * rl, O[dt][4 * a4 + 3] * rl)};
}
__device__ __forceinline__ void mem_attn_unit(Frame& F, int layer, int u, int qcol) {
    const int hd = u & 3; int stream, row0, nrows;
    if (u < 256) { stream = 0; row0 = (u >> 2) * 256; nrows = 256; } else { const int b = (u - 256) >> 2; stream = 1 + b; row0 = SEQ + 64 * b; nrows = 64; }
    LAS bf16* Ks = (LAS bf16*)F.lds; LAS bf16* Vs = (LAS bf16*)(F.lds + 69632);
    const bf16* kg = kimg_ptr(F.ws, layer, stream, hd); const bf16* vg = kg + 32768;
    for (int p = F.tid; p < 4096; p += 512) { const int row = p >> 4, c = p & 15; *(LAS u32x4*)(Ks + row * 136 + 8 * c) = *(const u32x4*)(kg + row * 128 + 8 * c); }
    for (int p = F.tid; p < 4096; p += 512) { const int d = p >> 5, c = p & 31; const u32x4 v = *(const u32x4*)(vg + d * 256 + 8 * c);
        *(LAS u32x2*)(Vs + d * 260 + 8 * c) = (u32x2){v.x, v.y}; *(LAS u32x2*)(Vs + d * 260 + 8 * c + 4) = (u32x2){v.z, v.w}; }
    __syncthreads();
    if (32 * F.wave < nrows) {
        bf16* qrow = F.big + (size_t)(row0 + 32 * F.wave + (F.lane & 31)) * PITCH + qcol + 128 * hd;
        attn_core<128, 8, 136, 260>(Ks, Vs, qrow, 0.08838834764831845f, 0.f, false, 0, F.lane);
    }
    __syncthreads();
}
__device__ __forceinline__ void swa_unit(Frame& F, int cid, int kvh) {
    LAS bf16* Ks = (LAS bf16*)F.lds; LAS bf16* Vs = (LAS bf16*)(F.lds + 27648);
    const bool sample = cid >= 256; const int b = cid - 256;
    const float* kgain = F.inp(23); const float* qgain = F.inp(22);
    for (int p = F.tid; p < 1536; p += 512) {
        const int t = p >> 3, c8 = p & 7, d0 = 8 * c8;
        u32x4 kw = {0u, 0u, 0u, 0u}, vw = {0u, 0u, 0u, 0u};
        if (sample && t < 128) {
            const bf16* kc = (const bf16*)(F.ws + WS_SWAC) + ((size_t)b * 128 + t) * 256 + 64 * kvh + d0;
            kw = *(const u32x4*)kc; vw = *(const u32x4*)(kc + 8 * 128 * 256);
        } else {
            const int row = sample ? (SEQ + 64 * b + t - 128) : (64 * cid - 128 + t);
            float kf[8];
            if (row >= 0) { const bf16* src = F.big + (size_t)row * PITCH + C_K1 + 64 * kvh + d0; const u32x4 kr = *(const u32x4*)src; vw = *(const u32x4*)(src + 256);
                kf[0] = bflo(kr.x); kf[1] = bfhi(kr.x); kf[2] = bflo(kr.y); kf[3] = bfhi(kr.y); kf[4] = bflo(kr.z); kf[5] = bfhi(kr.z); kf[6] = bflo(kr.w); kf[7] = bfhi(kr.w); }
            else {
#pragma unroll
                for (int e = 0; e < 8; ++e) kf[e] = 0.f; }
            float ss = 0.f;
#pragma unroll
            for (int e = 0; e < 8; ++e) ss += kf[e] * kf[e];
            ss += __shfl_xor(ss, 1); ss += __shfl_xor(ss, 2); ss += __shfl_xor(ss, 4);
            const float inv = 1.0f / sqrtf(ss * (1.0f / 64.0f) + EPS);
            const f32x4 g0 = *(const f32x4*)(kgain + d0), g1 = *(const f32x4*)(kgain + d0 + 4), q0 = *(const f32x4*)(qgain + d0), q1 = *(const f32x4*)(qgain + d0 + 4);
            float kn[8] = {kf[0] * inv * g0.x, kf[1] * inv * g0.y, kf[2] * inv * g0.z, kf[3] * inv * g0.w, kf[4] * inv * g1.x, kf[5] * inv * g1.y, kf[6] * inv * g1.z, kf[7] * inv * g1.w};
            if (t >= 128 && (sample || cid >= 254)) {
                const size_t o = sample ? ((size_t)((b * 64 + (t - 128)) * 4 + kvh) * 64 + d0) : ((size_t)((row - (SEQ - 128)) * 4 + kvh) * 64 + d0);
                float* ko = F.out + (sample ? O_KS : O_KP) + o; float* vo = F.out + (sample ? O_VS : O_VP) + o;
                *(f32x4*)ko = (f32x4){kn[0], kn[1], kn[2], kn[3]}; *(f32x4*)(ko + 4) = (f32x4){kn[4], kn[5], kn[6], kn[7]};
                *(f32x4*)vo = (f32x4){bflo(vw.x), bfhi(vw.x), bflo(vw.y), bfhi(vw.y)}; *(f32x4*)(vo + 4) = (f32x4){bflo(vw.z), bfhi(vw.z), bflo(vw.w), bfhi(vw.w)};
            }
            kw = (u32x4){pk2(kn[0] * q0.x, kn[1] * q0.y), pk2(kn[2] * q0.z, kn[3] * q0.w), pk2(kn[4] * q1.x, kn[5] * q1.y), pk2(kn[6] * q1.z, kn[7] * q1.w)};
        }
        *(LAS u32x4*)(Ks + t * 72 + d0) = kw;
        LAS bf16* vt = Vs + d0 * 196 + t;
        vt[0] = (bf16)(vw.x & 0xffffu); vt[196] = (bf16)(vw.x >> 16); vt[2 * 196] = (bf16)(vw.y & 0xffffu); vt[3 * 196] = (bf16)(vw.y >> 16);
        vt[4 * 196] = (bf16)(vw.z & 0xffffu); vt[5 * 196] = (bf16)(vw.z >> 16); vt[6 * 196] = (bf16)(vw.w & 0xffffu); vt[7 * 196] = (bf16)(vw.w >> 16);
    }
    __syncthreads();
    {
        const int hq = 4 * kvh + (F.wave >> 1);
        bf16* qrow = F.big + (size_t)(64 * cid + 32 * (F.wave & 1) + (F.lane & 31)) * PITCH + C_Q1 + 64 * hq;
        const int lo = sample ? 0 : (128 - 64 * cid);
        attn_core<64, 6, 72, 196>(Ks, Vs, qrow, 0.125f, F.inp(24)[hq], true, lo, F.lane);
    }
    __syncthreads();
}

struct SchedT {
    pg8::TileOrder T; const char* A; const char* B; size_t astep, bstep;
    __device__ bool next(int i, pg8::Unit& u) const {
        const long L = (long)i * T.G + T.c;
        if (!T.tile(L, u.pm, u.pn)) return false;
        u.kind = 0; u.A = A + (size_t)u.pm * astep; u.B = B + (size_t)u.pn * bstep; return true;
    }
};
template <bool FROM_INPUT, bool WRITE_XB>
struct EpiRes {
    static constexpr bool PERM = false;
    const float* xp; const float* xs; float* out; bf16* big; float* rss;
    __device__ __forceinline__ void operator()(const f32x4 (&acc)[2][2][4][2], const pg8::Unit& u, int wr, int wc, int fr, int fq) const {
        asm volatile("" : "+v"(fr), "+v"(fq));
        const int row0 = u.pm * 256 + wr * 64 + fr, col0 = u.pn * 256 + wc * 32 + 4 * fq;
#pragma unroll
        for (int ai = 0; ai < 2; ++ai)
#pragma unroll
            for (int m = 0; m < 4; ++m) {
                const int row = row0 + ai * 128 + m * 16;
                const float* base = FROM_INPUT ? (row < SEQ ? xp + (size_t)row * D : xs + (size_t)(row - SEQ) * D) : out + (size_t)row * D;
                float* o = out + (size_t)row * D; float ss = 0.f;
#pragma unroll
                for (int bj = 0; bj < 2; ++bj)
#pragma unroll
                    for (int n = 0; n < 2; ++n) {
                        const int c = col0 + bj * 128 + n * 16;
                        const f32x4 x = *(const f32x4*)(base + c) + acc[ai][bj][m][n];
                        *(f32x4*)(o + c) = x;
                        if (WRITE_XB) { *(u32x2*)(big + (size_t)row * PITCH + C_XB + c) = (u32x2){pk2(x.x, x.y), pk2(x.z, x.w)}; ss += (x.x * x.x + x.y * x.y) + (x.z * x.z + x.w * x.w); }
                    }
                if (WRITE_XB) { ss += __shfl_xor(ss, 16); ss += __shfl_xor(ss, 32); if (fq == 0) atomicAdd(rss + row, ss); }
                asm volatile("" ::: "memory");
            }
    }
};
struct EpiSwiglu {
    static constexpr bool PERM = true;
    bf16* big; const float* rss;
    __device__ __forceinline__ void operator()(const f32x4 (&acc)[2][2][4][2], const pg8::Unit& u, int wr, int wc, int fr, int fq) const {
        asm volatile("" : "+v"(fr), "+v"(fq));
        const int row0 = u.pm * 256 + wr * 64 + fr, col = C_ACT + u.pn * 128 + wc * 32 + 8 * fq;
#pragma unroll
        for (int ai = 0; ai < 2; ++ai)
#pragma unroll
            for (int m = 0; m < 4; ++m) {
                const int row = row0 + ai * 128 + m * 16;
                const float inv = 1.0f / sqrtf(rss[row] * (1.0f / 1024.0f) + EPS);
                float a[8];
#pragma unroll
                for (int n = 0; n < 2; ++n)
#pragma unroll
                    for (int j = 0; j < 4; ++j) { const float g = acc[ai][0][m][n][j] * inv, up = acc[ai][1][m][n][j] * inv; a[4 * n + j] = silu_f(g) * up; }
                *(u32x4*)(big + (size_t)row * PITCH + col) = (u32x4){pk2(a[0], a[1]), pk2(a[2], a[3]), pk2(a[4], a[5]), pk2(a[6], a[7])};
            }
    }
};
struct EpiScale {
    static constexpr bool PERM = true;
    bf16* big; const float* rss; int colbase;
    __device__ __forceinline__ void operator()(const f32x4 (&acc)[2][2][4][2], const pg8::Unit& u, int wr, int wc, int fr, int fq) const {
        asm volatile("" : "+v"(fr), "+v"(fq));
        const int row0 = u.pm * 256 + wr * 64 + fr, col = colbase + u.pn * 256 + wc * 32 + 8 * fq;
#pragma unroll
        for (int ai = 0; ai < 2; ++ai)
#pragma unroll
            for (int m = 0; m < 4; ++m) {
                const int row = row0 + ai * 128 + m * 16;
                const float inv = 1.0f / sqrtf(rss[row] * (1.0f / 1024.0f) + EPS);
#pragma unroll
                for (int bj = 0; bj < 2; ++bj) {
                    const f32x4 v0 = acc[ai][bj][m][0] * inv, v1 = acc[ai][bj][m][1] * inv;
                    *(u32x4*)(big + (size_t)row * PITCH + col + bj * 128) = (u32x4){pk2(v0[0], v0[1]), pk2(v0[2], v0[3]), pk2(v1[0], v1[1]), pk2(v1[2], v1[3])};
                }
            }
    }
};
template <class Epi>
__device__ __forceinline__ void run_gemm(Frame& F, int nN, int K, int acol, size_t wofs, const Epi& E) {
    SchedT S; S.T.init(66, nN, F.G, F.bid); S.A = (const char*)(F.big + acol); S.B = (const char*)(F.ws + wofs); S.astep = (size_t)256 * PITCH * 2; S.bstep = (size_t)256 * K * 2;
    pg8::gemm_phase<Epi, SchedT>(F.lds, F.tid, K, PITCH, S, E);
}

__global__ void __launch_bounds__(512, 2) mega_fwd(Args args) {
    extern __shared__ __attribute__((aligned(16))) unsigned char lds_raw[];
    Frame F;
    F.lds = (LAS unsigned char*)lds_raw;
    F.tid = threadIdx.x; F.lane = F.tid & 63; F.wave = __builtin_amdgcn_readfirstlane(F.tid >> 6);
    F.G = gridDim.x; F.bid = blockIdx.x;
    F.ka = (const float* const*)__builtin_amdgcn_kernarg_segment_ptr(); F.out = args.out; F.ws = args.ws;
    F.ctl = (gu32*)(args.ws + WS_CTL);
    F.big = (bf16*)(args.ws + WS_BIG);
    volatile LAS unsigned* MISC = (volatile LAS unsigned*)(F.lds + MISC_OFF);
    if (F.tid < 64) MISC[F.tid] = 0u;
    __syncthreads();
    XcdBarrier bar = xcd_barrier_post((unsigned*)(F.ctl + CW_BAR), MISC + 8);
#define GRID_BAR() do { xcd_barrier(bar); PHASE_FENCE(); } while (0)

    p0_prologue(F);
    GRID_BAR();
    if (LAST_PHASE < 1) return;
    {
        SchedP1 S; S.T.init(66, 19, F.G, F.bid); S.A = (const char*)F.out; S.B = (const char*)(F.ws + WS_WA); S.Amem = (const char*)(F.ws + WS_MEMB); S.Bmem = (const char*)(F.ws + WS_WMEM);
        EpiP1 E{F.big, (bf16*)(F.ws + WS_HALO), (float*)(F.ws + WS_BA), (const float*)(F.ws + WS_ROWSS0), (float*)(F.ws + WS_KVRAW), F.out};
        pg8::gemm_phase<EpiP1, SchedP1>(F.lds, F.tid, 1024, 1024, S, E);
    }
    GRID_BAR();
    if (LAST_PHASE < 2) return;
    fix_items(F, F.bid * 8 + F.wave, F.G * 8);
    for (int u = F.bid; u < NCH * 4; u += F.G) prep_unit(F, u >> 2, u & 3);
    GRID_BAR();
    if (LAST_PHASE < 3) return;
    if (F.bid < 8) gdn_scan(F, 0, 256, F.bid, nullptr, F.out + O_STATE_P + (size_t)F.bid * 16384);
    else if (F.bid < 72) { const int t = F.bid - 8, b = t >> 3, h = t & 7; gdn_scan(F, 256 + b, 1, h, F.inp(5) + (size_t)(b * 8 + h) * 16384, F.out + O_STATE_S + (size_t)(b * 8 + h) * 16384); }
    else for (int u = F.bid - 72; u < 288; u += F.G - 72) mem_attn_unit(F, 0, u, C_QM0);
    GRID_BAR();
    if (LAST_PHASE < 4) return;
    float* rss1 = (float*)(F.ctl + CW_RSS1); float* rss2 = (float*)(F.ctl + CW_RSS2); float* rss3 = (float*)(F.ctl + CW_RSS3);
    { EpiRes<true, true> E{F.inp(0), F.inp(1), F.out, F.big, rss1}; run_gemm(F, 4, 1536, C_Z, WS_WOA, E); }
    GRID_BAR();
    { EpiSwiglu E{F.big, rss1}; run_gemm(F, 22, 1024, C_XB, WS_WGU0, E); }
    GRID_BAR();
    { EpiRes<false, true> E{nullptr, nullptr, F.out, F.big, rss2}; run_gemm(F, 4, 2816, C_ACT, WS_WD0, E); }
    GRID_BAR();
    if (LAST_PHASE < 8) return;
    { EpiScale E{F.big, rss2, C_Q1}; run_gemm(F, 8, 1024, C_XB, WS_WB, E); }
    GRID_BAR();
    for (int u = F.bid; u < 1056 + 288; u += F.G) { if (u < 1056) swa_unit(F, u >> 2, u & 3); else mem_attn_unit(F, 1, u - 1056, C_QM1); }
    GRID_BAR();
    { EpiRes<false, true> E{nullptr, nullptr, F.out, F.big, rss3}; run_gemm(F, 4, 1536, C_Q1, WS_WOB, E); }
    GRID_BAR();
    { EpiSwiglu E{F.big, rss3}; run_gemm(F, 22, 1024, C_XB, WS_WGU1, E); }
    GRID_BAR();
    { EpiRes<false, false> E{nullptr, nullptr, F.out, F.big, nullptr}; run_gemm(F, 4, 2816, C_ACT, WS_WD1, E); }
#ifdef DBG_ZERO
    {
        const size_t gt = (size_t)F.bid * 512 + F.tid, GT = (size_t)F.G * 512;
        for (size_t i = gt; i < O_STATE_P; i += GT) F.out[i] = 0.f;
        for (size_t i = O_KP + gt; i < O_MEMK; i += GT) F.out[i] = 0.f;
        for (size_t i = O_STATE_P + gt; i < O_CONV_P; i += GT) F.out[i] *= 3.f;
    }
#endif
}

extern "C" void kernel_launch(void* const* d_in, const int* in_sizes, int n_in, void* d_out, int out_size, void* d_ws, size_t ws_size, hipStream_t stream) {
    static int grid = 0;
    if (grid == 0) {
        int dev = 0, cus = 0, per_cu = 0;
        if (n_in != 28 || ws_size < WS_END) { fprintf(stderr, "kernel_launch: unexpected n_in %d / ws %zu\n", n_in, ws_size); grid = -1; return; }
        if (hipGetDevice(&dev) != hipSuccess || hipDeviceGetAttribute(&cus, hipDeviceAttributeMultiprocessorCount, dev) != hipSuccess) { grid = -1; return; }
        if (hipFuncSetAttribute((const void*)mega_fwd, hipFuncAttributeMaxDynamicSharedMemorySize, LDS_BYTES) != hipSuccess) { fprintf(stderr, "kernel_launch: hipFuncSetAttribute failed\n"); grid = -1; return; }
        if (hipOccupancyMaxActiveBlocksPerMultiprocessor(&per_cu, (const void*)mega_fwd, 512, LDS_BYTES) != hipSuccess || per_cu < 1) { fprintf(stderr, "kernel_launch: occupancy query says %d\n", per_cu); per_cu = 1; }
        (void)hipGetLastError();
        grid = cus;
    }
    if (grid < 0) return;
    (void)hipMemsetAsync((char*)d_ws + WS_CTL, 0, CTL_ZERO_BYTES, stream);
    Args a{};
    for (int i = 0; i < 28; ++i) a.in[i] = (const float*)d_in[i];
    a.out = (float*)d_out; a.ws = (unsigned char*)d_ws;
    hipLaunchKernelGGL(mega_fwd, dim3(grid), dim3(512), LDS_BYTES, stream, a);
}
```

```cpp
#include <hip/hip_runtime.h>
#include <cstdio>
#include <cstdint>

#define LAS __attribute__((address_space(3)))
#define GAS __attribute__((address_space(1)))
typedef unsigned short bf16;
typedef short bf16x8 __attribute__((ext_vector_type(8)));
typedef short s16x4 __attribute__((ext_vector_type(4)));
typedef float f32x4 __attribute__((ext_vector_type(4)));
typedef float f32x2 __attribute__((ext_vector_type(2)));
typedef float f32x16 __attribute__((ext_vector_type(16)));
typedef unsigned u32x4 __attribute__((ext_vector_type(4)));
typedef unsigned u32x2 __attribute__((ext_vector_type(2)));
typedef GAS unsigned gu32;

#ifndef PROBE_A
#define PROBE_A -1
#endif
#ifndef LAST_PHASE
#define LAST_PHASE 99
#endif

constexpr int D = 1024, SEQ = 16384, NTOK = 16896, NCH = 264  ;
constexpr int PITCH = 4608;
constexpr int DFF = 2816;
constexpr float EPS = 1e-6f;
constexpr int C_Z = 3072, C_QM0 = 4096;
constexpr int C_XB = 0, C_ACT = 1024, C_Q1 = 1024, C_QM1 = 2048, C_K1 = 2560, C_V1 = 2816;

constexpr size_t O_Y = 0, O_STATE_P = 17301504, O_CONV_P = 17432576, O_STATE_S = 17441792, O_CONV_S = 18490368, O_KP = 18564096, O_VP = 18596864,
                 O_KS = 18629632, O_VS = 18760704, O_MEMK = 18891776, O_MEMV = 19153920;

constexpr size_t MiB = 1u << 20;
constexpr size_t WS_CTL = 0, CTL_ZERO_BYTES = 1 * MiB;
constexpr size_t WS_ROWSS0 = 1 * MiB;
constexpr size_t WS_BA = 2 * MiB;
constexpr size_t WS_HALO = 4 * MiB;
constexpr size_t WS_KVRAW = 9 * MiB;
constexpr size_t WS_MEMB = 11 * MiB;
constexpr size_t WS_ACHUNK = 11 * MiB + 768 * 1024;
constexpr size_t WS_SWAC = 12 * MiB;
constexpr size_t WS_KVIMG = 13 * MiB;
constexpr size_t WS_MG = 22 * MiB;
constexpr size_t WS_HSLOT = 30 * MiB;
constexpr size_t WS_WA = 46 * MiB;
constexpr size_t WS_WOA = WS_WA + (size_t)4864 * 1024 * 2;
constexpr size_t WS_WGU0 = WS_WOA + (size_t)1024 * 1536 * 2;
constexpr size_t WS_WD0 = WS_WGU0 + (size_t)5632 * 1024 * 2;
constexpr size_t WS_WB = WS_WD0 + (size_t)1024 * 2816 * 2;
constexpr size_t WS_WOB = WS_WB + (size_t)2048 * 1024 * 2;
constexpr size_t WS_WGU1 = WS_WOB + (size_t)1024 * 1536 * 2;
constexpr size_t WS_WD1 = WS_WGU1 + (size_t)5632 * 1024 * 2;
constexpr size_t WS_WMEM = WS_WD1 + (size_t)1024 * 2816 * 2;
constexpr size_t WS_WEND = WS_WMEM + (size_t)2 * 1024 * 1024 * 2;
constexpr size_t WS_BIG = 103 * MiB;
constexpr size_t WS_END = WS_BIG + (size_t)NTOK * PITCH * 2;
static_assert(WS_WEND <= WS_BIG && WS_END <= 256 * MiB, "d_ws map");
constexpr int CW_BAR = 4096;
constexpr int CW_RSS1 = 65536, CW_RSS2 = CW_RSS1 + 16896, CW_RSS3 = CW_RSS2 + 16896;
static_assert((CW_RSS3 + 16896) * 4 <= (int)CTL_ZERO_BYTES, "ctl");
constexpr size_t QX_BYTES = 24576;

constexpr int RING_BYTES = 131072;
constexpr int MISC_OFF = 143360;
constexpr int LDS_BYTES = 147456;

#define RLX_AGENT __ATOMIC_RELAXED, __HIP_MEMORY_SCOPE_AGENT
#define LDS_WAIT() asm volatile("s_waitcnt lgkmcnt(0)" ::: "memory")
#define VM_WAIT() asm volatile("s_waitcnt vmcnt(0)" ::: "memory")
typedef __bf16 bf16x2_t __attribute__((ext_vector_type(2)));
__device__ __forceinline__ unsigned pk2(float lo, float hi) { f32x2 v = {lo, hi}; bf16x2_t b = __builtin_convertvector(v, bf16x2_t); return __builtin_bit_cast(unsigned, b); }
__device__ __forceinline__ float bf2f(unsigned short b) { return __uint_as_float((unsigned)b << 16); }
__device__ __forceinline__ float bflo(unsigned w) { return __uint_as_float(w << 16); }
__device__ __forceinline__ float bfhi(unsigned w) { return __uint_as_float(w & 0xffff0000u); }
__device__ __forceinline__ float wave_sum(float v) {
#pragma unroll
    for (int o = 1; o < 64; o <<= 1) v += __shfl_xor(v, o);
    return v;
}
__device__ __forceinline__ float fast_exp(float x) { return __builtin_amdgcn_exp2f(x * 1.4426950408889634f); }
__device__ __forceinline__ float silu_f(float x) { return x / (1.0f + __expf(-x)); }

#define XB_TMO      128
#define XB_XCNT(j)  (256  + 64 * (j))
#define XB_XSUB(j)  (1280 + 64 * (j))
#define XB_XGEN(j)  (2304 + 64 * (j))
#define XB_TOP      3328
#define XB_TOPGEN   3392
#define XCD_BAR_WORDS 3456
#define XB_SPIN_CAP (1u << 22)
__device__ __forceinline__ unsigned xb_ld(unsigned* p)              { return __hip_atomic_load(p, __ATOMIC_RELAXED, __HIP_MEMORY_SCOPE_AGENT); }
__device__ __forceinline__ unsigned xb_add(unsigned* p, unsigned v) { return __hip_atomic_fetch_add(p, v, __ATOMIC_RELAXED, __HIP_MEMORY_SCOPE_AGENT); }
__device__ __forceinline__ unsigned xb_xcc_id() { return (unsigned)__builtin_amdgcn_s_getreg((3 << 11) | 20) & 0xFu; }
#define XB_SPIN(cond, bar) do { unsigned _sp = 0; while (cond) { __builtin_amdgcn_s_sleep(1); \
    if ((++_sp & 255u) == 0u) { if (xb_ld(&(bar)[XB_TMO])) break; if (_sp > XB_SPIN_CAP) { atomicAdd(&(bar)[XB_TMO], 1u); break; } } } } while (0)
struct XcdBarrier { unsigned* bar; unsigned x; volatile LAS unsigned* st; };
__device__ __forceinline__ XcdBarrier xcd_barrier_post(unsigned* bar, volatile LAS unsigned* st) {
    XcdBarrier b; b.bar = bar; b.x = xb_xcc_id(); b.st = st;
    if (threadIdx.x == 0) (void)xb_add(&bar[XB_XCNT(b.x)], 1u);
    return b;
}
__device__ __forceinline__ void xcd_barrier_complete(unsigned* bar, unsigned x, unsigned& nloc, unsigned& nx) {
    const unsigned G = gridDim.x * gridDim.y * gridDim.z;
    unsigned sum, cnt, mine, sp = 0u;
    for (;;) {
        sum = 0u; cnt = 0u; mine = 0u;
#pragma unroll
        for (unsigned j = 0; j < 16; ++j) { const unsigned c = xb_ld(&bar[XB_XCNT(j)]); sum += c; cnt += (c > 0u) ? 1u : 0u; mine = (j == x) ? c : mine; }
        if (sum == G) break;
        __builtin_amdgcn_s_sleep(1);
        if ((++sp & 255u) == 0u) { if (xb_ld(&bar[XB_TMO])) break; if (sp > XB_SPIN_CAP) { atomicAdd(&bar[XB_TMO], 1u); break; } }
    }
    nloc = mine > 0u ? mine : 1u; nx = cnt > 0u ? cnt : 1u;
}
__device__ __forceinline__ void xcd_barrier(const XcdBarrier& b) {
    asm volatile("s_waitcnt vmcnt(0)" ::: "memory");
    __syncthreads();
    if (threadIdx.x == 0) {
        unsigned* bar = b.bar;
        __builtin_amdgcn_s_waitcnt(0);
        unsigned nloc = b.st[0], nx = b.st[1];
        if (nloc == 0u) { xcd_barrier_complete(bar, b.x, nloc, nx); b.st[0] = nloc; b.st[1] = nx; }
        const unsigned old = xb_add(&bar[XB_XSUB(b.x)], 1u);
        const unsigned gen = old / nloc;
        if (old + 1u == (gen + 1u) * nloc) {
            __builtin_amdgcn_fence(__ATOMIC_RELEASE, "agent");
            asm volatile("s_waitcnt vmcnt(0)" ::: "memory");
            const unsigned og = xb_add(&bar[XB_TOP], 1u);
            const unsigned tg = og / nx;
            if (og + 1u == (tg + 1u) * nx) xb_add(&bar[XB_TOPGEN], 1u);
            else XB_SPIN(xb_ld(&bar[XB_TOPGEN]) == tg, bar);
            __builtin_amdgcn_fence(__ATOMIC_ACQUIRE, "agent");
            xb_add(&bar[XB_XGEN(b.x)], 1u);
            asm volatile("s_waitcnt vmcnt(0)" ::: "memory");
        } else {
            XB_SPIN(xb_ld(&bar[XB_XGEN(b.x)]) == gen, bar);
            __builtin_amdgcn_fence(__ATOMIC_ACQUIRE, "agent");
            asm volatile("s_waitcnt vmcnt(0)" ::: "memory");
        }
    }
    __syncthreads();
}

struct Args { const float* in[28]; float* out; unsigned char* ws; };
struct Frame {
    LAS unsigned char* lds;
    gu32* ctl;
    int tid, lane, wave, G, bid;
    const float* const* ka;
    float* out; unsigned char* ws;
    bf16* big;
    __device__ __forceinline__ const float* inp(int k) const { return ka[k]; }
};
#define PHASE_FENCE() do { int t_ = F.tid; asm volatile("" : "+v"(t_)); F.tid = t_; F.lane = t_ & 63; const float* const* k_ = F.ka; asm volatile("" : "+s"(k_)); F.ka = k_; } while (0)

namespace pg8 {
constexpr int BM = 256, BK = 64, HALF = 128, HTB = HALF * BK * 2, STAGE_BYTES = 8 * HTB, NXCD = 8, WGM = 8;
__host__ __device__ __forceinline__ int lds_byte(int r, int c) { const int st = (r >> 4) * 2 + (c >> 5), rr = r & 15, cc = c & 31, ob = rr * 64 + cc * 2; return st * 1024 + (ob ^ (((ob >> 9) & 1) << 5)); }
__host__ __device__ __forceinline__ void stage_rc(int b, int& R, int& C) { const int st = b / 1024, sb = b % 1024, swz = sb ^ (((sb >> 9) & 1) << 5); R = (st >> 1) * 16 + swz / 64; C = (st & 1) * 32 + (swz % 64) / 2; }
__host__ __device__ __forceinline__ int perm32(int rho) { const int n = rho >> 4, i = rho & 15; return 8 * (i >> 2) + 4 * n + (i & 3); }

struct Unit { int pm, pn, kind; const char* A; const char* B; };
struct TileOrder {
    int nM, nN, nwg, G, c;
    __device__ void init(int nM_, int nN_, int G_, int c_) { nM = nM_; nN = nN_; nwg = nM * nN; G = G_; c = c_; }
    __device__ bool tile(long L, int& pm, int& pn) const {
        if (L >= nwg) return false;
        int wgid = (int)L; { const int q = nwg / NXCD, r = nwg % NXCD, xcd = wgid % NXCD, off = wgid / NXCD; wgid = (xcd < r ? xcd * (q + 1) : r * (q + 1) + (xcd - r) * q) + off; }
        const int nig = WGM * nN, gid = wgid / nig, fm = gid * WGM, gsz = (nM - fm) < WGM ? (nM - fm) : WGM;
        pm = fm + ((wgid % nig) % gsz); pn = (wgid % nig) / gsz; return true;
    }
};

template <class Epi, class Sched>
__device__ __forceinline__ void gemm_phase(LAS unsigned char* lds, const int tid, const int K, const int lda, const Sched& S, const Epi& E) {
    const int wid = __builtin_amdgcn_readfirstlane(tid >> 6), lane = tid & 63, wr = wid >> 2, wc = wid & 3, fr = lane & 15, fq = lane >> 4;
    const int nt = K / BK;
    unsigned voffA[2], voffB[2];
#pragma unroll
    for (int i = 0; i < 2; ++i) { int R, C; stage_rc(tid * 16 + i * 8192, R, C); const int Rb = Epi::PERM ? ((R & ~31) + perm32(R & 31)) : R;
        voffA[i] = (unsigned)(R * lda + C) * 2u; voffB[i] = (unsigned)(Rb * K + C) * 2u; }
    const size_t kstep = (size_t)(BK * 2);
    const size_t hstepA = (size_t)HALF * lda * 2, hstepB = (size_t)HALF * K * 2;
    const unsigned ldsw = (unsigned)wid * 1024u;
    const int aoff = lds_byte(wr * 64 + fr, fq * 8), boff = lds_byte(wc * 32 + fr, fq * 8);
#define PG8_SA(b, h) (((b) * 2 + (h)) * HTB)
#define PG8_SB(b, h) ((4 + (b) * 2 + (h)) * HTB)
#define PG8_STAGE(bufoff, gbase, voff) do { _Pragma("unroll") for (int _i = 0; _i < 2; ++_i) \
        __builtin_amdgcn_global_load_lds((const unsigned*)((const char*)(gbase) + (voff)[_i]), (LAS unsigned*)(lds + (bufoff) + ldsw + _i * 8192), 16, 0, 0); } while (0)
#define PG8_LDA(dst, b, h) do { _Pragma("unroll") for (int m = 0; m < 4; ++m) _Pragma("unroll") for (int k = 0; k < 2; ++k) dst[m][k] = *(const LAS bf16x8*)(lds + PG8_SA(b, h) + aoff + m * 2048 + k * 1024); } while (0)
#define PG8_LDB(dst, b, h) do { _Pragma("unroll") for (int n = 0; n < 2; ++n) _Pragma("unroll") for (int k = 0; k < 2; ++k) dst[n][k] = *(const LAS bf16x8*)(lds + PG8_SB(b, h) + boff + n * 2048 + k * 1024); } while (0)
#define PG8_MMA(ai, bj, At, Bt) do { __builtin_amdgcn_s_setprio(1); _Pragma("unroll") for (int m = 0; m < 4; ++m) _Pragma("unroll") for (int n = 0; n < 2; ++n) _Pragma("unroll") for (int k = 0; k < 2; ++k) \
        acc[ai][bj][m][n] = __builtin_amdgcn_mfma_f32_16x16x32_bf16(Bt[n][k], At[m][k], acc[ai][bj][m][n], 0, 0, 0); __builtin_amdgcn_s_setprio(0); } while (0)
#define PG8_WAIT_V(n) asm volatile("s_waitcnt vmcnt(" #n ")" ::: "memory")
#define PG8_WAIT_L(n) asm volatile("s_waitcnt lgkmcnt(" #n ")" ::: "memory")
#define PG8_BAR __builtin_amdgcn_s_barrier()
#define PG8_SCHED __builtin_amdgcn_sched_barrier(0)
    Unit cur, nxt; int ui = 0;
    if (!S.next(0, cur)) return;
    f32x4 acc[2][2][4][2];
#pragma unroll
    for (int a = 0; a < 2; ++a)
#pragma unroll
        for (int b = 0; b < 2; ++b)
#pragma unroll
            for (int m = 0; m < 4; ++m)
#pragma unroll
                for (int n = 0; n < 2; ++n) acc[a][b][m][n] = (f32x4){0.f, 0.f, 0.f, 0.f};
    bf16x8 At[4][2], B0[2][2], B1[2][2];
    const char* cA = cur.A; const char* cB = cur.B;
    PG8_STAGE(PG8_SB(0, 0), cB, voffB); PG8_STAGE(PG8_SB(0, 1), cB + hstepB, voffB); PG8_STAGE(PG8_SA(0, 0), cA, voffA); PG8_STAGE(PG8_SA(0, 1), cA + hstepA, voffA);
    if (wr == 1) PG8_BAR;
    PG8_WAIT_V(2); PG8_BAR;
    PG8_STAGE(PG8_SB(1, 0), cB + kstep, voffB); PG8_STAGE(PG8_SA(1, 0), cA + kstep, voffA); PG8_STAGE(PG8_SB(1, 1), cB + hstepB + kstep, voffB);
    PG8_WAIT_V(6); PG8_BAR;
    for (;;) {
        const bool has_next = S.next(ui + 1, nxt);
        const char* nA = has_next ? nxt.A : cA; const char* nB = has_next ? nxt.B : cB;
        for (int t = 0; t < nt; t += 2) {
            const bool last = (t == nt - 2);
            const char* a1 = cA + (size_t)(t + 1) * kstep;
            const char* a2 = last ? nA : cA + (size_t)(t + 2) * kstep; const char* b2 = last ? nB : cB + (size_t)(t + 2) * kstep;
            const char* a3 = a2 + kstep; const char* b3 = b2 + kstep;
            PG8_LDB(B0, 0, 0); PG8_LDB(B1, 0, 1); PG8_SCHED; PG8_LDA(At, 0, 0); PG8_STAGE(PG8_SA(1, 1), a1 + hstepA, voffA);
            PG8_WAIT_V(8); PG8_WAIT_L(0); PG8_BAR; PG8_MMA(0, 0, At, B0); PG8_MMA(0, 1, At, B1); PG8_BAR; PG8_SCHED;
            PG8_LDA(At, 0, 1); PG8_STAGE(PG8_SB(0, 0), b2, voffB); PG8_STAGE(PG8_SB(0, 1), b2 + hstepB, voffB); PG8_STAGE(PG8_SA(0, 0), a2, voffA);
            PG8_WAIT_V(8); PG8_WAIT_L(0); PG8_BAR; PG8_MMA(1, 0, At, B0); PG8_MMA(1, 1, At, B1); PG8_BAR; PG8_SCHED;
            PG8_LDB(B0, 1, 0); PG8_LDB(B1, 1, 1); PG8_SCHED; PG8_LDA(At, 1, 0); PG8_STAGE(PG8_SA(0, 1), a2 + hstepA, voffA);
            PG8_WAIT_V(8); PG8_WAIT_L(0); PG8_BAR; PG8_MMA(0, 0, At, B0); PG8_MMA(0, 1, At, B1); PG8_BAR; PG8_SCHED;
            PG8_LDA(At, 1, 1); PG8_STAGE(PG8_SB(1, 0), b3, voffB); PG8_STAGE(PG8_SB(1, 1), b3 + hstepB, voffB); PG8_STAGE(PG8_SA(1, 0), a3, voffA);
            PG8_WAIT_V(8); PG8_WAIT_L(0); PG8_BAR; PG8_MMA(1, 0, At, B0); PG8_MMA(1, 1, At, B1); PG8_BAR; PG8_SCHED;
        }
        if (wr == 0) PG8_BAR;
        E(acc, cur, wr, wc, fr, fq);
        if (!has_next) break;
#pragma unroll
        for (int a = 0; a < 2; ++a)
#pragma unroll
            for (int b = 0; b < 2; ++b)
#pragma unroll
                for (int m = 0; m < 4; ++m)
#pragma unroll
                    for (int n = 0; n < 2; ++n) acc[a][b][m][n] = (f32x4){0.f, 0.f, 0.f, 0.f};
        cur = nxt; cA = nA; cB = nB; ++ui;
        if (wr == 1) PG8_BAR;
    }
    PG8_WAIT_V(0);
    PG8_BAR;
#undef PG8_SA
#undef PG8_SB
#undef PG8_STAGE
#undef PG8_LDA
#undef PG8_LDB
#undef PG8_MMA
#undef PG8_WAIT_V
#undef PG8_WAIT_L
#undef PG8_BAR
#undef PG8_SCHED
}
}

__device__ __forceinline__ void tr_item(const float* W, int ldw, bf16* WT, int K, int k0, int dst_row0, int src_col0, int nvalid, const float* gain, LAS float* scr, int lane) {
    const int n = lane & 31;
#pragma unroll 8
    for (int i = 0; i < 32; ++i) { const int kk = 2 * i + (lane >> 5);
        float v = (n < nvalid) ? W[(size_t)(k0 + kk) * ldw + src_col0 + n] : 0.f;
        if (gain) v *= gain[k0 + kk];
        scr[kk * 33 + n] = v; }
    LDS_WAIT(); asm volatile("" ::: "memory");
    const int c = lane & 7;
#pragma unroll
    for (int j = 0; j < 4; ++j) { const int nn = (lane >> 3) + 8 * j; const LAS float* s = scr + (8 * c) * 33 + nn;
        u32x4 o; o.x = pk2(s[0 * 33], s[1 * 33]); o.y = pk2(s[2 * 33], s[3 * 33]); o.z = pk2(s[4 * 33], s[5 * 33]); o.w = pk2(s[6 * 33], s[7 * 33]);
        *(GAS u32x4*)(WT + (size_t)(dst_row0 + nn) * K + k0 + 8 * c) = o; }
    LDS_WAIT(); asm volatile("" ::: "memory");
}
__device__ __forceinline__ void wt_item(Frame& F, int it, LAS float* scr) {
    const float* W; int ldw, K, nblk, map; bf16* dst; const float* gain;
    int r = it;
    if (r < 2432) { W = F.inp(15); ldw = 4624; K = 1024; nblk = 152; map = 1; dst = (bf16*)(F.ws + WS_WA); gain = F.inp(9); }
    else if ((r -= 2432) < 768) { W = F.inp(20); ldw = 1024; K = 1536; nblk = 32; map = 0; dst = (bf16*)(F.ws + WS_WOA); gain = nullptr; }
    else if ((r -= 768) < 2816) { W = F.inp(26); ldw = 5632; K = 1024; nblk = 176; map = 2; dst = (bf16*)(F.ws + WS_WGU0); gain = F.inp(10); }
    else if ((r -= 2816) < 1408) { W = F.inp(27); ldw = 1024; K = 2816; nblk = 32; map = 0; dst = (bf16*)(F.ws + WS_WD0); gain = nullptr; }
    else if ((r -= 1408) < 1024) { W = F.inp(21); ldw = 2048; K = 1024; nblk = 64; map = 3; dst = (bf16*)(F.ws + WS_WB); gain = F.inp(9) + 1024; }
    else if ((r -= 1024) < 768) { W = F.inp(25); ldw = 1024; K = 1536; nblk = 32; map = 0; dst = (bf16*)(F.ws + WS_WOB); gain = nullptr; }
    else if ((r -= 768) < 2816) { W = F.inp(26) + (size_t)1024 * 5632; ldw = 5632; K = 1024; nblk = 176; map = 2; dst = (bf16*)(F.ws + WS_WGU1); gain = F.inp(10) + 1024; }
    else if ((r -= 2816) < 1408) { W = F.inp(27) + (size_t)2816 * 1024; ldw = 1024; K = 2816; nblk = 32; map = 0; dst = (bf16*)(F.ws + WS_WD1); gain = nullptr; }
    else if ((r -= 1408) < 512) { W = F.inp(12); ldw = 1024; K = 1024; nblk = 32; map = 0; dst = (bf16*)(F.ws + WS_WMEM); gain = F.inp(11); }
    else { r -= 512; W = F.inp(12) + (size_t)1024 * 1024; ldw = 1024; K = 1024; nblk = 32; map = 0; dst = (bf16*)(F.ws + WS_WMEM) + (size_t)1024 * 1024; gain = F.inp(11) + 1024; }
    const int kb = r / nblk, nb = r % nblk;
    int src0 = 32 * nb, nv = 32;
    if (map == 1) { if (nb < 128) { src0 = 32 * nb; } else if (nb < 144) { src0 = 4112 + 32 * (nb - 128); } else if (nb == 144) { src0 = 4096; nv = 16; } else { src0 = 0; nv = 0; } }
    else if (map == 2) { const int pn = nb >> 3, w = nb & 7; src0 = (w < 4) ? (128 * pn + 32 * w) : (2816 + 128 * pn + 32 * (w - 4)); }
    else if (map == 3) { if (nb < 32) src0 = 32 * nb; else if (nb < 48) src0 = 1536 + 32 * (nb - 32); else src0 = 1024 + 32 * (nb - 48); }
    tr_item(W, ldw, dst, K, 64 * kb, 32 * nb, src0, nv, gain, scr, F.lane);
}
constexpr int N_WT_ITEMS = 14464;
__device__ __forceinline__ void row_to_bf16(const float* xrow, bf16* orow, float* ss, int lane) {
    const GAS f32x4* xr = (const GAS f32x4*)xrow + lane;
    f32x4 v[4]; float s = 0.f;
#pragma unroll
    for (int j = 0; j < 4; ++j) { v[j] = xr[64 * j]; s += (v[j].x * v[j].x + v[j].y * v[j].y) + (v[j].z * v[j].z + v[j].w * v[j].w); }
    s = wave_sum(s);
    GAS u32x2* o8 = (GAS u32x2*)orow + lane;
#pragma unroll
    for (int j = 0; j < 4; ++j) { u32x2 w; w.x = pk2(v[j].x, v[j].y); w.y = pk2(v[j].z, v[j].w); o8[64 * j] = w; }
    if (lane == 0) *ss = s;
}
__device__ __forceinline__ void p0_prologue(Frame& F) {
    LAS float* scr = (LAS float*)(F.lds + F.wave * 16384);
    const int gw = F.bid * 8 + F.wave, NGW = F.G * 8;
    for (int it = gw; it < N_WT_ITEMS; it += NGW) wt_item(F, it, scr);
    bf16* xb = (bf16*)F.out;
    float* rss0 = (float*)(F.ws + WS_ROWSS0);
    for (int m = gw; m < NTOK + 256; m += NGW) {
        if (m < SEQ) row_to_bf16(F.inp(0) + (size_t)m * D, xb + (size_t)m * D, rss0 + m, F.lane);
        else if (m < NTOK) row_to_bf16(F.inp(1) + (size_t)(m - SEQ) * D, xb + (size_t)m * D, rss0 + m, F.lane);
        else row_to_bf16(F.inp(2) + (size_t)(m - NTOK) * D, (bf16*)(F.ws + WS_MEMB) + (size_t)(m - NTOK) * D, rss0 + m, F.lane);
    }
}

struct SchedP1 {
    pg8::TileOrder T; const char* A; const char* B; const char* Amem; const char* Bmem;
    __device__ bool next(int i, pg8::Unit& u) const {
        const long L = (long)i * T.G + T.c;
        if (L < T.nwg) { T.tile(L, u.pm, u.pn); u.kind = 0; u.A = A + (size_t)u.pm * 256 * 1024 * 2; u.B = B + (size_t)u.pn * 256 * 1024 * 2; return true; }
        const int e = (int)(L - T.nwg); if (e >= 8) return false;
        u.pm = 0; u.pn = e; u.kind = 1; u.A = Amem; u.B = Bmem + (size_t)e * 256 * 1024 * 2; return true;
    }
};
struct EpiP1 {
    static constexpr bool PERM = true;
    bf16* big; bf16* halo; float* ba; const float* rss0; float* kvraw; float* out;
    __device__ __forceinline__ void operator()(const f32x4 (&acc)[2][2][4][2], const pg8::Unit& u, int wr, int wc, int fr, int fq) const {
        asm volatile("" : "+v"(fr), "+v"(fq));
        if (u.kind == 0) {
            const int row0 = u.pm * 256 + wr * 64 + fr, colb = u.pn * 256 + wc * 32 + 8 * fq;
#pragma unroll
            for (int ai = 0; ai < 2; ++ai)
#pragma unroll
                for (int m = 0; m < 4; ++m) {
                    const int row = row0 + ai * 128 + m * 16;
                    const float inv = 1.0f / sqrtf(rss0[row] * (1.0f / 1024.0f) + EPS);
#pragma unroll
                    for (int bj = 0; bj < 2; ++bj) {
                        const f32x4 v0 = acc[ai][bj][m][0] * inv, v1 = acc[ai][bj][m][1] * inv; const int col = colb + bj * 128;
                        if (u.pn < 18) {
                            u32x4 w; w.x = pk2(v0[0], v0[1]); w.y = pk2(v0[2], v0[3]); w.z = pk2(v1[0], v1[1]); w.w = pk2(v1[2], v1[3]);
                            *(u32x4*)(big + (size_t)row * PITCH + col) = w;
                            if (m == 3 && fr >= 13 && u.pn < 12) {
                                const int cid = row >> 6, j = fr - 13;
                                *(u32x4*)(halo + ((size_t)cid * 3 + j) * 3072 + col) = w;
                                if (cid >= 255) { float* o = (cid == 255) ? out + O_CONV_P + (size_t)j * 3072 + col : out + O_CONV_S + ((size_t)(cid - 256) * 3 + j) * 3072 + col;
                                    *(f32x4*)o = v0; *(f32x4*)(o + 4) = v1; }
                            }
                        } else if (bj == 0 && wc == 0 && fq < 2) {
                            float* o = ba + (size_t)row * 16 + 8 * fq; *(f32x4*)o = v0; *(f32x4*)(o + 4) = v1;
                        }
                    }
                }
        } else {
            const int layer = u.pn >> 2, pnn = u.pn & 3;
            const int row0 = wr * 64 + fr, colb = pnn * 256 + wc * 32 + 8 * fq;
#pragma unroll
            for (int ai = 0; ai < 2; ++ai)
#pragma unroll
                for (int m = 0; m < 4; ++m) {
                    const int row = row0 + ai * 128 + m * 16;
                    const float inv = 1.0f / sqrtf(rss0[NTOK + row] * (1.0f / 1024.0f) + EPS);
#pragma unroll
                    for (int bj = 0; bj < 2; ++bj) {
                        float* o = kvraw + ((size_t)layer * 256 + row) * 1024 + colb + bj * 128;
                        *(f32x4*)o = acc[ai][bj][m][0] * inv; *(f32x4*)(o + 4) = acc[ai][bj][m][1] * inv;
                    }
                }
        }
    }
};

__device__ __forceinline__ bf16* kimg_ptr(unsigned char* ws, int layer, int stream, int head) { return (bf16*)(ws + WS_KVIMG) + ((size_t)((layer * 9 + stream) * 4 + head)) * 65536; }
__device__ __forceinline__ bf16* vtimg_ptr(unsigned char* ws, int layer, int stream, int head) { return kimg_ptr(ws, layer, stream, head) + 32768; }
__device__ __forceinline__ void fix_items(Frame& F, int gw, int NGW) {
    const int lane = F.lane;
    for (int it = gw; it < 512; it += NGW) {
        const int layer = it >> 8, m = it & 255;
        const float* src = (const float*)(F.ws + WS_KVRAW) + ((size_t)layer * 256 + m) * 1024 + 16 * lane;
        f32x4 v[4];
#pragma unroll
        for (int j = 0; j < 4; ++j) v[j] = *(const f32x4*)(src + 4 * j);
        const int col = 16 * lane;
        if (col < 512) {
            float s = 0.f;
#pragma unroll
            for (int j = 0; j < 4; ++j) s += (v[j].x * v[j].x + v[j].y * v[j].y) + (v[j].z * v[j].z + v[j].w * v[j].w);
            s += __shfl_xor(s, 1); s += __shfl_xor(s, 2); s += __shfl_xor(s, 4);
            const float inv = 1.0f / sqrtf(s * (1.0f / 128.0f) + EPS);
            const int hd = col >> 7, d0 = col & 127;
            const float* kg = F.inp(14) + layer * 128 + d0; const float* qg = F.inp(13) + layer * 128 + d0;
            float* o = F.out + O_MEMK + ((size_t)layer * 256 + m) * 512 + col;
            bf16* ki = kimg_ptr(F.ws, layer, 0, hd) + (size_t)m * 128 + d0;
            unsigned pw[8];
#pragma unroll
            for (int j = 0; j < 4; ++j) { f32x4 g = *(const f32x4*)(kg + 4 * j), q = *(const f32x4*)(qg + 4 * j); f32x4 r = v[j] * inv * g; *(f32x4*)(o + 4 * j) = r; r = r * q; pw[2 * j] = pk2(r.x, r.y); pw[2 * j + 1] = pk2(r.z, r.w); }
            *(u32x4*)ki = (u32x4){pw[0], pw[1], pw[2], pw[3]}; *(u32x4*)(ki + 8) = (u32x4){pw[4], pw[5], pw[6], pw[7]};
        } else {
            const int c2 = col - 512, hd = c2 >> 7, d0 = c2 & 127;
            float* o = F.out + O_MEMV + ((size_t)layer * 256 + m) * 512 + c2;
            bf16* vt = vtimg_ptr(F.ws, layer, 0, hd);
#pragma unroll
            for (int j = 0; j < 4; ++j) { *(f32x4*)(o + 4 * j) = v[j];
#pragma unroll
                for (int e = 0; e < 4; ++e) vt[(size_t)(d0 + 4 * j + e) * 256 + m] = (bf16)(pk2(v[j][e], 0.f) & 0xffffu); }
        }
    }
    for (int it = gw; it < 4096; it += NGW) {
        const int layer = it >> 11, b = (it >> 8) & 7, m = it & 255;
        const size_t base = (((size_t)layer * 8 + b) * 256 + m) * 512 + 8 * lane;
        const int hd = (8 * lane) >> 7, d0 = (8 * lane) & 127;
        const f32x4 k0 = *(const f32x4*)(F.inp(3) + base), k1 = *(const f32x4*)(F.inp(3) + base + 4);
        const f32x4 v0 = *(const f32x4*)(F.inp(4) + base), v1 = *(const f32x4*)(F.inp(4) + base + 4);
        const float* qg = F.inp(13) + layer * 128 + d0; const f32x4 q0 = *(const f32x4*)qg, q1 = *(const f32x4*)(qg + 4);
        const f32x4 a = k0 * q0, c = k1 * q1;
        *(u32x4*)(kimg_ptr(F.ws, layer, 1 + b, hd) + (size_t)m * 128 + d0) = (u32x4){pk2(a.x, a.y), pk2(a.z, a.w), pk2(c.x, c.y), pk2(c.z, c.w)};
        bf16* vt = vtimg_ptr(F.ws, layer, 1 + b, hd);
#pragma unroll
        for (int e = 0; e < 4; ++e) { vt[(size_t)(d0 + e) * 256 + m] = (bf16)(pk2(v0[e], 0.f) & 0xffffu); vt[(size_t)(d0 + 4 + e) * 256 + m] = (bf16)(pk2(v1[e], 0.f) & 0xffffu); }
    }
    for (int it = gw; it < 1024; it += NGW) {
        const size_t base = (size_t)it * 256 + 4 * lane; const int d0 = (4 * lane) & 63;
        const f32x4 k = *(const f32x4*)(F.inp(7) + base), v = *(const f32x4*)(F.inp(8) + base), q = *(const f32x4*)(F.inp(22) + d0);
        const f32x4 a = k * q;
        bf16* ko = (bf16*)(F.ws + WS_SWAC) + base; bf16* vo = ko + 8 * 128 * 256;
        *(u32x2*)ko = (u32x2){pk2(a.x, a.y), pk2(a.z, a.w)}; *(u32x2*)vo = (u32x2){pk2(v.x, v.y), pk2(v.z, v.w)};
    }
}

constexpr int PREP_HALF = 71680;
constexpr int PR_KT = 0, PR_QT = 17408, PR_VB = 34816, PR_AM = 52224  , PR_BETA = 70464, PR_CUM = 70720, PR_GSC = 70976, PR_G = 71232;
static_assert(2 * PREP_HALF <= MISC_OFF && PR_AM + 18224 <= PR_BETA, "prep LDS");
__device__ __forceinline__ void conv8(const LAS bf16* rawp, const float* wp, float (&o)[8]) {
#pragma unroll
    for (int e = 0; e < 8; ++e) o[e] = 0.f;
#pragma unroll
    for (int tap = 0; tap < 4; ++tap) {
        const u32x4 r = *(const LAS u32x4*)(rawp + tap * 136);
        const f32x4 w0 = *(const f32x4*)(wp + tap * 3072), w1 = *(const f32x4*)(wp + tap * 3072 + 4);
        o[0] += bflo(r.x) * w0.x; o[1] += bfhi(r.x) * w0.y; o[2] += bflo(r.y) * w0.z; o[3] += bfhi(r.y) * w0.w;
        o[4] += bflo(r.z) * w1.x; o[5] += bfhi(r.z) * w1.y; o[6] += bflo(r.w) * w1.z; o[7] += bfhi(r.w) * w1.w;
    }
#pragma unroll
    for (int e = 0; e < 8; ++e) o[e] = silu_f(o[e]);
}
__device__ __forceinline__ int crow32(int g, int hh) { return (g & 3) + 8 * (g >> 2) + 4 * hh; }
__device__ __forceinline__ bf16 f2b(float v) { return (bf16)(pk2(v, 0.f) & 0xffffu); }
__device__ __forceinline__ void prep_unit(Frame& F, int cid, int hp) {
    const int hw = F.wave >> 2, h = 2 * hp + hw, th = F.tid & 255, wv = F.wave & 3, lane = F.lane;
    LAS unsigned char* L = F.lds + hw * PREP_HALF;
    LAS bf16* raw = (LAS bf16*)(L + PR_AM);
    LAS bf16* kt = (LAS bf16*)(L + PR_KT); LAS bf16* qt = (LAS bf16*)(L + PR_QT); LAS bf16* vb = (LAS bf16*)(L + PR_VB);
    LAS float* Am = (LAS float*)(L + PR_AM);
    LAS float* beta = (LAS float*)(L + PR_BETA); LAS float* cum = (LAS float*)(L + PR_CUM); LAS float* gsc = (LAS float*)(L + PR_GSC); LAS float* gtmp = (LAS float*)(L + PR_G);
    bf16* bigrow = F.big + (size_t)cid * 64 * PITCH;
    if (th < 64) {
        const float* bap = (const float*)(F.ws + WS_BA) + ((size_t)cid * 64 + th) * 16;
        const float braw = bap[h], araw = bap[8 + h];
        const float x = araw + F.inp(18)[h];
        const float sp = (x > 20.f) ? x : log1pf(__expf(x));
        gtmp[th] = -__expf(F.inp(17)[h]) * sp;
        beta[th] = 1.0f / (1.0f + __expf(-braw));
    }
    __syncthreads();
    if (th < 64) { float c = 0.f; for (int j = 0; j <= th; ++j) c += gtmp[j]; cum[th] = c; gsc[th] = beta[th] * __expf(c); }
    const int i = th >> 2, seg = th & 3;
#pragma unroll 1
    for (int part = 0; part < 3; ++part) {
        const int colg = part * 1024 + 128 * h;
        for (int p = th; p < 1072; p += 256) {
            const int j = p >> 4, c16 = p & 15; const int col = colg + 8 * c16;
            u32x4 v;
            if (j >= 3) v = *(const u32x4*)(bigrow + (unsigned)((j - 3) * PITCH + col));
            else if (cid == 0) v = (u32x4){0u, 0u, 0u, 0u};
            else if (cid < 256) v = *(const u32x4*)((const bf16*)(F.ws + WS_HALO) + ((size_t)(cid - 1) * 3 + j) * 3072 + col);
            else { const float* sp = F.inp(6) + ((size_t)(cid - 256) * 3 + j) * 3072 + col; const f32x4 a = *(const f32x4*)sp, b = *(const f32x4*)(sp + 4);
                   v = (u32x4){pk2(a.x, a.y), pk2(a.z, a.w), pk2(b.x, b.y), pk2(b.z, b.w)}; }
            *(LAS u32x4*)(raw + j * 136 + 8 * c16) = v;
        }
        __syncthreads();
        float xv[32];
        const float* cw = F.inp(16) + colg + seg * 32;
#pragma unroll
        for (int g8 = 0; g8 < 4; ++g8) {
            float o[8];
            conv8(raw + i * 136 + seg * 32 + g8 * 8, cw + g8 * 8, o);
#pragma unroll
            for (int e = 0; e < 8; ++e) xv[g8 * 8 + e] = o[e];
            asm volatile("" ::: "memory");
        }
        float sc;
        if (part < 2) {
            float ss = 0.f;
#pragma unroll
            for (int e = 0; e < 32; ++e) ss += xv[e] * xv[e];
            ss += __shfl_xor(ss, 1); ss += __shfl_xor(ss, 2);
            sc = 1.0f / sqrtf(ss + EPS); if (part == 0) sc *= 0.08838834764831845f;
        } else sc = beta[i];
        LAS bf16* dst = (part == 0 ? qt : (part == 1 ? kt : vb)) + i * 136 + seg * 32;
#pragma unroll
        for (int g8 = 0; g8 < 4; ++g8)
            *(LAS u32x4*)(dst + g8 * 8) = (u32x4){pk2(xv[g8*8+0] * sc, xv[g8*8+1] * sc), pk2(xv[g8*8+2] * sc, xv[g8*8+3] * sc), pk2(xv[g8*8+4] * sc, xv[g8*8+5] * sc), pk2(xv[g8*8+6] * sc, xv[g8*8+7] * sc)};
        __syncthreads();
    }
    bf16* qx = (bf16*)F.out + (size_t)(cid * 8 + h) * 12288;
    {
        const int ti = wv >> 1, tj = wv & 1, r = lane & 31, hh = lane >> 5;
        f32x16 kk, qk;
#pragma unroll
        for (int g = 0; g < 16; ++g) { kk[g] = 0.f; qk[g] = 0.f; }
#pragma unroll
        for (int s = 0; s < 8; ++s) {
            const bf16x8 a = *(const LAS bf16x8*)(kt + (32 * ti + r) * 136 + 16 * s + 8 * hh);
            const bf16x8 q = *(const LAS bf16x8*)(qt + (32 * ti + r) * 136 + 16 * s + 8 * hh);
            const bf16x8 b = *(const LAS bf16x8*)(kt + (32 * tj + r) * 136 + 16 * s + 8 * hh);
            kk = __builtin_amdgcn_mfma_f32_32x32x16_bf16(a, b, kk, 0, 0, 0);
            qk = __builtin_amdgcn_mfma_f32_32x32x16_bf16(q, b, qk, 0, 0, 0);
        }
        const int j = 32 * tj + r; const float cj = cum[j];
#pragma unroll
        for (int g = 0; g < 16; ++g) {
            int hh_ = hh; asm volatile("" : "+v"(hh_));
            const int ii = 32 * ti + crow32(g, hh_);
            const float dec = __expf(fminf(cum[ii] - cj, 0.f));
            Am[ii * 68 + j] = (ii > j) ? beta[ii] * kk[g] * dec : 0.f;
            const float qm = (ii >= j) ? qk[g] * dec : 0.f;
            qx[(unsigned)(8192 + ii * 64 + (((j >> 3) ^ ((ii >> 1) & 7)) << 3) + (j & 7))] = f2b(qm);
            asm volatile("" ::: "memory");
        }
    }
    __syncthreads();
    {
        const int c = th;
        float sol[64];
        const LAS bf16* rp = (c < 128) ? (vb + c) : (kt + (c - 128));
        const int w = c >> 4, col = c & 15, kk = c - 128;
        bf16* vbase = bigrow + 2048 + 128 * h; bf16* wbase = bigrow + 128 * h;
#pragma unroll
        for (int ii = 0; ii < 64; ++ii) {
            float v = bf2f(rp[ii * 136]); if (c >= 128) v *= gsc[ii];
            int kk_ = kk, col_ = col; asm volatile("" : "+v"(kk_), "+v"(col_));
#pragma unroll
            for (int j4 = 0; j4 < (ii + 3) / 4; ++j4) {
                const f32x4 a = *(const LAS f32x4*)(Am + ii * 68 + 4 * j4);
                v -= a.x * sol[4 * j4];
                if (4 * j4 + 1 < ii) v -= a.y * sol[4 * j4 + 1];
                if (4 * j4 + 2 < ii) v -= a.z * sol[4 * j4 + 2];
                if (4 * j4 + 3 < ii) v -= a.w * sol[4 * j4 + 3];
            }
            sol[ii] = v;
            if (c >= 128) wbase[(unsigned)(ii * PITCH + ((((kk_ >> 3) ^ (ii & 15)) << 3) + (kk_ & 7)))] = f2b(v);
            else if ((ii & 3) == 3) {
                const int t4 = ii >> 4, q = (ii >> 2) & 3; const int e = (((w * 4 + t4) * 4 + q) * 16 + col_) * 4;
                *(u32x2*)(vbase + (unsigned)((e >> 7) * PITCH + (e & 127))) = (u32x2){pk2(sol[ii - 3], sol[ii - 2]), pk2(sol[ii - 1], sol[ii])};
            }
            asm volatile("" ::: "memory");
        }
    }
    {
        const float clast = cum[63];
        bf16* kbase = bigrow + 1024 + 128 * h;
#pragma unroll 1
        for (int pp = 0; pp < 4; ++pp) {
            const int p = th + 256 * pp, kk = p >> 3, c16 = p & 7;
            float v[8];
#pragma unroll
            for (int e = 0; e < 8; ++e) { const int ii = 8 * c16 + e; v[e] = bf2f(kt[ii * 136 + kk]) * __expf(clast - cum[ii]); }
            const int e0 = kk * 64 + ((c16 ^ ((kk >> 1) & 7)) << 3);
            *(u32x4*)(kbase + (unsigned)((e0 >> 7) * PITCH + (e0 & 127))) = (u32x4){pk2(v[0], v[1]), pk2(v[2], v[3]), pk2(v[4], v[5]), pk2(v[6], v[7])};
        }
#pragma unroll 1
        for (int pp = 0; pp < 4; ++pp) {
            const int p = th + 256 * pp, ii = p >> 4, c16 = p & 15;
            const u32x4 r = *(const LAS u32x4*)(qt + ii * 136 + 8 * c16); const float ec = __expf(cum[ii]);
            *(u32x4*)(qx + (unsigned)(ii * 128 + ((c16 ^ (ii & 15)) << 3))) = (u32x4){pk2(bflo(r.x) * ec, bfhi(r.x) * ec), pk2(bflo(r.y) * ec, bfhi(r.y) * ec), pk2(bflo(r.z) * ec, bfhi(r.z) * ec), pk2(bflo(r.w) * ec, bfhi(r.w) * ec)};
        }
        if (th == 0) ((float*)(F.ws + WS_ACHUNK))[cid * 8 + h] = __expf(clast);
    }
    __syncthreads();
}

constexpr int EN_STAGE = 57344, EN_W = 0, EN_KDT = 16384, EN_QD = 32768, EN_QK = 49152, EN_SSQ = 2 * EN_STAGE;
__device__ __forceinline__ void en_stage(Frame& F, int cid, int h, int st) {
    const bf16* big = F.big; const int lane = F.lane;
#pragma unroll
    for (int k = 0; k < 7; ++k) {
        const int piece = F.wave + 8 * k;
        const char* g;
        if (piece < 32) { const int o = (piece & 15) * 1024 + lane * 16; g = (const char*)(big + ((size_t)cid * 64 + (o >> 8)) * PITCH + (piece < 16 ? 0 : 1024) + 128 * h) + (o & 255); }
        else g = (const char*)((const bf16*)F.out + (size_t)(cid * 8 + h) * 12288) + (piece - 32) * 1024 + lane * 16;
        __builtin_amdgcn_global_load_lds((const unsigned*)g, (LAS unsigned*)(F.lds + st * EN_STAGE + piece * 1024), 16, 0, 0);
    }
}
__device__ __forceinline__ bf16x8 pack2(const f32x4& a, const f32x4& b) { u32x4 p = {pk2(a.x, a.y), pk2(a.z, a.w), pk2(b.x, b.y), pk2(b.z, b.w)}; return __builtin_bit_cast(bf16x8, p); }
__device__ __forceinline__ bf16x8 ld_frag(const LAS unsigned char* p0, const LAS unsigned char* p1) { const u32x2 a = *(const LAS u32x2*)p0, b = *(const LAS u32x2*)p1; u32x4 p = {a.x, a.y, b.x, b.y}; return __builtin_bit_cast(bf16x8, p); }
#define MFMA16(a, b, c) __builtin_amdgcn_mfma_f32_16x16x32_bf16((a), (b), (c), 0, 0, 0)
__device__ __forceinline__ void gdn_scan(Frame& F, int cid0, int n, int h, const float* hinit, float* hfinal) {
    const int w = F.wave, lane = F.lane, col = lane & 15, q = lane >> 4;
    bf16* big = F.big;
    LAS float* ssq = (LAS float*)(F.lds + EN_SSQ);
    f32x4 hS[8];
#pragma unroll
    for (int t = 0; t < 8; ++t) {
        if (hinit) { const float* p = hinit + (size_t)(16 * t + 4 * q) * 128 + 16 * w + col; hS[t] = (f32x4){p[0], p[128], p[256], p[384]}; }
        else hS[t] = (f32x4){0.f, 0.f, 0.f, 0.f};
    }
    if (F.tid < 128) ssq[F.tid] = 0.f;
    const float og = F.inp(19)[16 * w + col];
    u32x2 un[4];
    en_stage(F, cid0, h, 0);
#pragma unroll
    for (int t4 = 0; t4 < 4; ++t4) { const int e = (((w * 4 + t4) * 4 + q) * 16 + col) * 4; un[t4] = *(const u32x2*)(big + ((size_t)cid0 * 64 + (e >> 7)) * PITCH + 2048 + 128 * h + (e & 127)); }
    for (int s = 0; s < n; ++s) {
        const int cid = cid0 + s, st = s & 1;
        VM_WAIT(); __syncthreads();
        f32x4 u[4];
#pragma unroll
        for (int t4 = 0; t4 < 4; ++t4) u[t4] = (f32x4){bflo(un[t4].x), bfhi(un[t4].x), bflo(un[t4].y), bfhi(un[t4].y)};
        if (s + 1 < n) {
            en_stage(F, cid + 1, h, st ^ 1);
#pragma unroll
            for (int t4 = 0; t4 < 4; ++t4) { const int e = (((w * 4 + t4) * 4 + q) * 16 + col) * 4; un[t4] = *(const u32x2*)(big + ((size_t)(cid + 1) * 64 + (e >> 7)) * PITCH + 2048 + 128 * h + (e & 127)); }
        }
        if (F.tid < 64) ssq[(st ^ 1) * 64 + F.tid] = 0.f;
        bf16* zp0 = big + ((size_t)cid * 64 + 4 * q) * PITCH + C_Z + 128 * h + 16 * w + col;
        unsigned short zr[16];
#pragma unroll
        for (int t4 = 0; t4 < 4; ++t4)
#pragma unroll
            for (int r = 0; r < 4; ++r) zr[4 * t4 + r] = zp0[(unsigned)((16 * t4 + r) * PITCH)];
        const LAS unsigned char* SB = F.lds + st * EN_STAGE;
        const float ach = ((const float*)(F.ws + WS_ACHUNK))[cid * 8 + h];
        bf16x8 hB[4];
#pragma unroll
        for (int ks = 0; ks < 4; ++ks) hB[ks] = pack2(hS[2 * ks], hS[2 * ks + 1]);
        f32x4 vn[4], o[4];
#pragma unroll
        for (int t4 = 0; t4 < 4; ++t4) {
            const int row = 16 * t4 + col; f32x4 a = {0.f, 0.f, 0.f, 0.f}, b = {0.f, 0.f, 0.f, 0.f};
#pragma unroll
            for (int ks = 0; ks < 4; ++ks) {
                const int c16 = 4 * ks + (q >> 1), off0 = row * 256 + (((c16 ^ (row & 15)) << 3) + (q & 1) * 4) * 2, off1 = row * 256 + ((((c16 + 2) ^ (row & 15)) << 3) + (q & 1) * 4) * 2;
                a = MFMA16(ld_frag(SB + EN_W + off0, SB + EN_W + off1), hB[ks], a);
                b = MFMA16(ld_frag(SB + EN_QD + off0, SB + EN_QD + off1), hB[ks], b);
            }
            vn[t4] = u[t4] - a; o[t4] = b;
        }
        bf16x8 vB[2];
        vB[0] = pack2(vn[0], vn[1]); vB[1] = pack2(vn[2], vn[3]);
#pragma unroll
        for (int t4 = 0; t4 < 4; ++t4) {
            const int row = 16 * t4 + col;
#pragma unroll
            for (int cs = 0; cs < 2; ++cs) {
                if (32 * cs > 16 * t4 + 15) continue;
                const int c16 = 4 * cs + (q >> 1), sw = (row >> 1) & 7, off0 = row * 128 + (((c16 ^ sw) << 3) + (q & 1) * 4) * 2, off1 = row * 128 + ((((c16 + 2) ^ sw) << 3) + (q & 1) * 4) * 2;
                o[t4] = MFMA16(ld_frag(SB + EN_QK + off0, SB + EN_QK + off1), vB[cs], o[t4]);
            }
        }
#pragma unroll
        for (int t = 0; t < 8; ++t) {
            const int row = 16 * t + col; f32x4 a = hS[t] * ach;
#pragma unroll
            for (int cs = 0; cs < 2; ++cs) {
                const int c16 = 4 * cs + (q >> 1), sw = (row >> 1) & 7, off0 = row * 128 + (((c16 ^ sw) << 3) + (q & 1) * 4) * 2, off1 = row * 128 + ((((c16 + 2) ^ sw) << 3) + (q & 1) * 4) * 2;
                a = MFMA16(ld_frag(SB + EN_KDT + off0, SB + EN_KDT + off1), vB[cs], a);
            }
            hS[t] = a;
        }
#pragma unroll
        for (int t4 = 0; t4 < 4; ++t4)
#pragma unroll
            for (int r = 0; r < 4; ++r) {
                float v = o[t4][r] * o[t4][r];
                v += __shfl_xor(v, 1); v += __shfl_xor(v, 2); v += __shfl_xor(v, 4); v += __shfl_xor(v, 8);
                if (col == 0) atomicAdd((float*)(ssq + st * 64 + 16 * t4 + 4 * q + r), v);
            }
        __syncthreads();
#pragma unroll
        for (int t4 = 0; t4 < 4; ++t4)
#pragma unroll
            for (int r = 0; r < 4; ++r) {
                const int row = 16 * t4 + 4 * q + r;
                const float inv = 1.0f / sqrtf(ssq[st * 64 + row] * (1.0f / 128.0f) + EPS);
                const float z = bf2f(zr[4 * t4 + r]);
                zp0[(unsigned)((16 * t4 + r) * PITCH)] = f2b(o[t4][r] * inv * og * silu_f(z));
            }
    }
    if (hfinal) {
#pragma unroll
        for (int t = 0; t < 8; ++t) { float* p = hfinal + (size_t)(16 * t + 4 * q) * 128 + 16 * w + col; p[0] = hS[t].x; p[128] = hS[t].y; p[256] = hS[t].z; p[384] = hS[t].w; }
    }
    __syncthreads();
}

__device__ __forceinline__ void en_stage1(Frame& F, int cid, int h, int st) {
    const bf16* big = F.big; const int lane = F.lane;
#pragma unroll
    for (int k = 0; k < 4; ++k) {
        const int piece = F.wave + 8 * k; const int o = (piece & 15) * 1024 + lane * 16;
        const char* g = (const char*)(big + ((size_t)cid * 64 + (o >> 8)) * PITCH + (piece < 16 ? 0 : 1024) + 128 * h) + (o & 255);
        __builtin_amdgcn_global_load_lds((const unsigned*)g, (LAS unsigned*)(F.lds + st * 32768 + piece * 1024), 16, 0, 0);
    }
}
__device__ __forceinline__ void gdn_l1(Frame& F, int g, int h) {
    const int w = F.wave, lane = F.lane, col = lane & 15, q = lane >> 4, cid0 = 8 * g;
    const bf16* big = F.big;
    f32x4 hB[8], hP[8];
#pragma unroll
    for (int t = 0; t < 8; ++t) { hB[t] = (f32x4){0.f, 0.f, 0.f, 0.f};
#pragma unroll
        for (int r = 0; r < 4; ++r) hP[t][r] = (16 * t + 4 * q + r == 16 * w + col) ? 1.f : 0.f; }
    u32x2 un[4];
    en_stage1(F, cid0, h, 0);
#pragma unroll
    for (int t4 = 0; t4 < 4; ++t4) { const int e = (((w * 4 + t4) * 4 + q) * 16 + col) * 4; un[t4] = *(const u32x2*)(big + ((size_t)cid0 * 64 + (e >> 7)) * PITCH + 2048 + 128 * h + (e & 127)); }
#pragma unroll 1
    for (int s = 0; s < 8; ++s) {
        const int cid = cid0 + s, st = s & 1;
        VM_WAIT(); __syncthreads();
        f32x4 u[4];
#pragma unroll
        for (int t4 = 0; t4 < 4; ++t4) u[t4] = (f32x4){bflo(un[t4].x), bfhi(un[t4].x), bflo(un[t4].y), bfhi(un[t4].y)};
        if (s + 1 < 8) {
            en_stage1(F, cid + 1, h, st ^ 1);
#pragma unroll
            for (int t4 = 0; t4 < 4; ++t4) { const int e = (((w * 4 + t4) * 4 + q) * 16 + col) * 4; un[t4] = *(const u32x2*)(big + ((size_t)(cid + 1) * 64 + (e >> 7)) * PITCH + 2048 + 128 * h + (e & 127)); }
        }
        const LAS unsigned char* SB = F.lds + st * 32768;
        const float ach = ((const float*)(F.ws + WS_ACHUNK))[cid * 8 + h];
        bf16x8 fB[4], fP[4];
#pragma unroll
        for (int ks = 0; ks < 4; ++ks) { fB[ks] = pack2(hB[2 * ks], hB[2 * ks + 1]); fP[ks] = pack2(hP[2 * ks], hP[2 * ks + 1]); }
        f32x4 vnB[4], vnP[4];
#pragma unroll
        for (int t4 = 0; t4 < 4; ++t4) {
            const int row = 16 * t4 + col; f32x4 a = {0.f, 0.f, 0.f, 0.f}, b = {0.f, 0.f, 0.f, 0.f};
#pragma unroll
            for (int ks = 0; ks < 4; ++ks) {
                const int c16 = 4 * ks + (q >> 1), off0 = row * 256 + (((c16 ^ (row & 15)) << 3) + (q & 1) * 4) * 2, off1 = row * 256 + ((((c16 + 2) ^ (row & 15)) << 3) + (q & 1) * 4) * 2;
                const bf16x8 wf = ld_frag(SB + off0, SB + off1);
                a = MFMA16(wf, fB[ks], a); b = MFMA16(wf, fP[ks], b);
            }
            vnB[t4] = u[t4] - a; vnP[t4] = -b;
            asm volatile("" ::: "memory");
        }
        bf16x8 vB[2], vP[2];
        vB[0] = pack2(vnB[0], vnB[1]); vB[1] = pack2(vnB[2], vnB[3]); vP[0] = pack2(vnP[0], vnP[1]); vP[1] = pack2(vnP[2], vnP[3]);
#pragma unroll
        for (int t = 0; t < 8; ++t) {
            const int row = 16 * t + col; f32x4 a = hB[t] * ach, b = hP[t] * ach;
#pragma unroll
            for (int cs = 0; cs < 2; ++cs) {
                const int c16 = 4 * cs + (q >> 1), sw = (row >> 1) & 7, off0 = row * 128 + (((c16 ^ sw) << 3) + (q & 1) * 4) * 2, off1 = row * 128 + ((((c16 + 2) ^ sw) << 3) + (q & 1) * 4) * 2;
                const bf16x8 kf = ld_frag(SB + 16384 + off0, SB + 16384 + off1);
                a = MFMA16(kf, vB[cs], a); b = MFMA16(kf, vP[cs], b);
            }
            hB[t] = a; hP[t] = b;
            asm volatile("" ::: "memory");
        }
    }
    float* hs = (float*)(F.ws + WS_HSLOT) + ((size_t)g * 8 + h) * 16384;
    bf16* mg = (bf16*)(F.ws + WS_MG) + ((size_t)g * 8 + h) * 16384;
#pragma unroll
    for (int t = 0; t < 8; ++t) {
        int q_ = q, col_ = col; asm volatile("" : "+v"(q_), "+v"(col_));
        float* p = hs + (unsigned)((16 * t + 4 * q_) * 128 + 16 * w + col_); p[0] = hB[t].x; p[128] = hB[t].y; p[256] = hB[t].z; p[384] = hB[t].w;
#pragma unroll
        for (int r = 0; r < 4; ++r) { const int i = 16 * t + 4 * q_ + r, kk = 16 * w + col_; mg[(unsigned)(i * 128 + ((((kk >> 3) ^ (i & 15)) << 3) + (kk & 7)))] = f2b(hP[t][r]); }
        asm volatile("" ::: "memory");
    }
    __syncthreads();
}
__device__ __forceinline__ void en_stage2(Frame& F, int g, int h, int st) {
    const char* src = (const char*)((const bf16*)(F.ws + WS_MG) + ((size_t)g * 8 + h) * 16384);
#pragma unroll
    for (int k = 0; k < 4; ++k) { const int piece = F.wave + 8 * k;
        __builtin_amdgcn_global_load_lds((const unsigned*)(src + piece * 1024 + F.lane * 16), (LAS unsigned*)(F.lds + st * 32768 + piece * 1024), 16, 0, 0); }
}
__device__ __forceinline__ void gdn_l2(Frame& F, int h, float* hfinal) {
    const int w = F.wave, lane = F.lane, col = lane & 15, q = lane >> 4;
    f32x4 hS[8], bn[8];
#pragma unroll
    for (int t = 0; t < 8; ++t) hS[t] = (f32x4){0.f, 0.f, 0.f, 0.f};
    en_stage2(F, 0, h, 0);
    {
        const float* hs = (const float*)(F.ws + WS_HSLOT) + (size_t)h * 16384;
#pragma unroll
        for (int t = 0; t < 8; ++t) { const float* p = hs + (size_t)(16 * t + 4 * q) * 128 + 16 * w + col; bn[t] = (f32x4){p[0], p[128], p[256], p[384]}; }
    }
#pragma unroll 1
    for (int g = 0; g < 32; ++g) {
        const int st = g & 1;
        VM_WAIT(); __syncthreads();
        f32x4 acc[8];
#pragma unroll
        for (int t = 0; t < 8; ++t) acc[t] = bn[t];
        float* hs = (float*)(F.ws + WS_HSLOT) + ((size_t)g * 8 + h) * 16384;
        if (g + 1 < 32) {
            en_stage2(F, g + 1, h, st ^ 1);
            const float* hn = hs + 8 * 16384;
#pragma unroll
            for (int t = 0; t < 8; ++t) { const float* p = hn + (size_t)(16 * t + 4 * q) * 128 + 16 * w + col; bn[t] = (f32x4){p[0], p[128], p[256], p[384]}; }
        }
        const LAS unsigned char* SB = F.lds + st * 32768;
        bf16x8 fB[4];
#pragma unroll
        for (int ks = 0; ks < 4; ++ks) fB[ks] = pack2(hS[2 * ks], hS[2 * ks + 1]);
#pragma unroll
        for (int t = 0; t < 8; ++t) {
            const int row = 16 * t + col; f32x4 a = acc[t];
#pragma unroll
            for (int ks = 0; ks < 4; ++ks) {
                const int c16 = 4 * ks + (q >> 1), off0 = row * 256 + (((c16 ^ (row & 15)) << 3) + (q & 1) * 4) * 2, off1 = row * 256 + ((((c16 + 2) ^ (row & 15)) << 3) + (q & 1) * 4) * 2;
                a = MFMA16(ld_frag(SB + off0, SB + off1), fB[ks], a);
            }
            hS[t] = a;
            float* p = hs + (size_t)(16 * t + 4 * q) * 128 + 16 * w + col; p[0] = a.x; p[128] = a.y; p[256] = a.z; p[384] = a.w;
        }
    }
#pragma unroll
    for (int t = 0; t < 8; ++t) { float* p = hfinal + (size_t)(16 * t + 4 * q) * 128 + 16 * w + col; p[0] = hS[t].x; p[128] = hS[t].y; p[256] = hS[t].z; p[384] = hS[t].w; }
    __syncthreads();
}

#define MFMA32(a, b, c) __builtin_amdgcn_mfma_f32_32x32x16_bf16((a), (b), (c), 0, 0, 0)
template <int HD, int NKT, int KP, int VP>
__device__ __forceinline__ void attn_core(const LAS bf16* Ks, const LAS bf16* Vs, bf16* qrow, float scale, float sink, bool has_sink, int lo, int lane) {
    const int r = lane & 31, hh = lane >> 5;
    constexpr int NS = HD / 16, NDT = HD / 32;
    bf16x8 qf[NS]; float ss = 0.f;
#pragma unroll
    for (int s = 0; s < NS; ++s) {
        const u32x4 v = *(const u32x4*)(qrow + 16 * s + 8 * hh); qf[s] = __builtin_bit_cast(bf16x8, v);
        ss += bflo(v.x) * bflo(v.x) + bfhi(v.x) * bfhi(v.x) + bflo(v.y) * bflo(v.y) + bfhi(v.y) * bfhi(v.y) + bflo(v.z) * bflo(v.z) + bfhi(v.z) * bfhi(v.z) + bflo(v.w) * bflo(v.w) + bfhi(v.w) * bfhi(v.w);
    }
    ss += __shfl_xor(ss, 32);
    const float inv = (1.0f / sqrtf(ss * (1.0f / HD) + EPS)) * scale;
    float m = -INFINITY;
#pragma unroll 1
    for (int kt = 0; kt < NKT; ++kt) {
        f32x16 acc;
#pragma unroll
        for (int g = 0; g < 16; ++g) acc[g] = 0.f;
#pragma unroll
        for (int s = 0; s < NS; ++s) acc = MFMA32(*(const LAS bf16x8*)(Ks + (32 * kt + r) * KP + 16 * s + 8 * hh), qf[s], acc);
#pragma unroll
        for (int g = 0; g < 16; ++g) { const int key = 32 * kt + crow32(g, hh); float v = acc[g] * inv; if (key < lo) v = -INFINITY; m = fmaxf(m, v); }
    }
    m = fmaxf(m, __shfl_xor(m, 32)); if (has_sink) m = fmaxf(m, sink);
    float l = 0.f;
    f32x16 O[NDT];
#pragma unroll
    for (int dt = 0; dt < NDT; ++dt)
#pragma unroll
        for (int g = 0; g < 16; ++g) O[dt][g] = 0.f;
#pragma unroll 1
    for (int kt = 0; kt < NKT; ++kt) {
        f32x16 acc;
#pragma unroll
        for (int g = 0; g < 16; ++g) acc[g] = 0.f;
#pragma unroll
        for (int s = 0; s < NS; ++s) acc = MFMA32(*(const LAS bf16x8*)(Ks + (32 * kt + r) * KP + 16 * s + 8 * hh), qf[s], acc);
#pragma unroll
        for (int g = 0; g < 16; ++g) { const int key = 32 * kt + crow32(g, hh); float v = acc[g] * inv; if (key < lo) v = -INFINITY; const float pe = __expf(v - m); acc[g] = pe; l += pe; }
#pragma unroll
        for (int st = 0; st < 2; ++st) {
            const u32x4 pw = {pk2(acc[8 * st], acc[8 * st + 1]), pk2(acc[8 * st + 2], acc[8 * st + 3]), pk2(acc[8 * st + 4], acc[8 * st + 5]), pk2(acc[8 * st + 6], acc[8 * st + 7])};
            const bf16x8 pf = __builtin_bit_cast(bf16x8, pw);
#pragma unroll
            for (int dt = 0; dt < NDT; ++dt) {
                const LAS bf16* vp = Vs + (32 * dt + r) * VP + 32 * kt + 16 * st + 4 * hh;
                O[dt] = MFMA32(ld_frag((const LAS unsigned char*)vp, (const LAS unsigned char*)(vp + 8)), pf, O[dt]);
            }
        }
    }
    l += __shfl_xor(l, 32); if (has_sink) l += __expf(sink - m);
    const float rl = 1.0f / l;
#pragma unroll
    for (int dt = 0; dt < NDT; ++dt)
#pragma unroll
        for (int a4 = 0; a4 < 4; ++a4)
            *(u32x2*)(qrow + 32 * dt + 8 * a4 + 4 * hh) = (u32x2){pk2(O[dt][4 * a4] * rl, O[dt][4 * a4 + 1] * rl), pk2(O[dt][4 * a4 + 2] * rl, O[dt][4 * a4 + 3] * rl)};
}
__device__ __forceinline__ void mem_attn_unit(Frame& F, int layer, int u, int qcol) {
    const int hd = u & 3; int stream, row0, nrows;
    if (u < 256) { stream = 0; row0 = (u >> 2) * 256; nrows = 256; } else { const int b = (u - 256) >> 2; stream = 1 + b; row0 = SEQ + 64 * b; nrows = 64; }
    LAS bf16* Ks = (LAS bf16*)F.lds; LAS bf16* Vs = (LAS bf16*)(F.lds + 69632);
    const bf16* kg = kimg_ptr(F.ws, layer, stream, hd); const bf16* vg = kg + 32768;
    for (int p = F.tid; p < 4096; p += 512) { const int row = p >> 4, c = p & 15; *(LAS u32x4*)(Ks + row * 136 + 8 * c) = *(const u32x4*)(kg + row * 128 + 8 * c); }
    for (int p = F.tid; p < 4096; p += 512) { const int d = p >> 5, c = p & 31; const u32x4 v = *(const u32x4*)(vg + d * 256 + 8 * c);
        *(LAS u32x2*)(Vs + d * 260 + 8 * c) = (u32x2){v.x, v.y}; *(LAS u32x2*)(Vs + d * 260 + 8 * c + 4) = (u32x2){v.z, v.w}; }
    __syncthreads();
    if (32 * F.wave < nrows) {
        bf16* qrow = F.big + (size_t)(row0 + 32 * F.wave + (F.lane & 31)) * PITCH + qcol + 128 * hd;
        attn_core<128, 8, 136, 260>(Ks, Vs, qrow, 0.08838834764831845f, 0.f, false, 0, F.lane);
    }
    __syncthreads();
}
__device__ __forceinline__ void swa_unit(Frame& F, int cid, int kvh) {
    LAS bf16* Ks = (LAS bf16*)F.lds; LAS bf16* Vs = (LAS bf16*)(F.lds + 27648);
    const bool sample = cid >= 256; const int b = cid - 256;
    const float* kgain = F.inp(23); const float* qgain = F.inp(22);
    for (int p = F.tid; p < 1536; p += 512) {
        const int t = p >> 3, c8 = p & 7, d0 = 8 * c8;
        u32x4 kw = {0u, 0u, 0u, 0u}, vw = {0u, 0u, 0u, 0u};
        if (sample && t < 128) {
            const bf16* kc = (const bf16*)(F.ws + WS_SWAC) + ((size_t)b * 128 + t) * 256 + 64 * kvh + d0;
            kw = *(const u32x4*)kc; vw = *(const u32x4*)(kc + 8 * 128 * 256);
        } else {
            const int row = sample ? (SEQ + 64 * b + t - 128) : (64 * cid - 128 + t);
            float kf[8];
            if (row >= 0) { const bf16* src = F.big + (size_t)row * PITCH + C_K1 + 64 * kvh + d0; const u32x4 kr = *(const u32x4*)src; vw = *(const u32x4*)(src + 256);
                kf[0] = bflo(kr.x); kf[1] = bfhi(kr.x); kf[2] = bflo(kr.y); kf[3] = bfhi(kr.y); kf[4] = bflo(kr.z); kf[5] = bfhi(kr.z); kf[6] = bflo(kr.w); kf[7] = bfhi(kr.w); }
            else {
#pragma unroll
                for (int e = 0; e < 8; ++e) kf[e] = 0.f; }
            float ss = 0.f;
#pragma unroll
            for (int e = 0; e < 8; ++e) ss += kf[e] * kf[e];
            ss += __shfl_xor(ss, 1); ss += __shfl_xor(ss, 2); ss += __shfl_xor(ss, 4);
            const float inv = 1.0f / sqrtf(ss * (1.0f / 64.0f) + EPS);
            const f32x4 g0 = *(const f32x4*)(kgain + d0), g1 = *(const f32x4*)(kgain + d0 + 4), q0 = *(const f32x4*)(qgain + d0), q1 = *(const f32x4*)(qgain + d0 + 4);
            float kn[8] = {kf[0] * inv * g0.x, kf[1] * inv * g0.y, kf[2] * inv * g0.z, kf[3] * inv * g0.w, kf[4] * inv * g1.x, kf[5] * inv * g1.y, kf[6] * inv * g1.z, kf[7] * inv * g1.w};
            if (t >= 128 && (sample || cid >= 254)) {
                const size_t o = sample ? ((size_t)((b * 64 + (t - 128)) * 4 + kvh) * 64 + d0) : ((size_t)((row - (SEQ - 128)) * 4 + kvh) * 64 + d0);
                float* ko = F.out + (sample ? O_KS : O_KP) + o; float* vo = F.out + (sample ? O_VS : O_VP) + o;
                *(f32x4*)ko = (f32x4){kn[0], kn[1], kn[2], kn[3]}; *(f32x4*)(ko + 4) = (f32x4){kn[4], kn[5], kn[6], kn[7]};
                *(f32x4*)vo = (f32x4){bflo(vw.x), bfhi(vw.x), bflo(vw.y), bfhi(vw.y)}; *(f32x4*)(vo + 4) = (f32x4){bflo(vw.z), bfhi(vw.z), bflo(vw.w), bfhi(vw.w)};
            }
            kw = (u32x4){pk2(kn[0] * q0.x, kn[1] * q0.y), pk2(kn[2] * q0.z, kn[3] * q0.w), pk2(kn[4] * q1.x, kn[5] * q1.y), pk2(kn[6] * q1.z, kn[7] * q1.w)};
        }
        *(LAS u32x4*)(Ks + t * 72 + d0) = kw;
        LAS bf16* vt = Vs + d0 * 196 + t;
        vt[0] = (bf16)(vw.x & 0xffffu); vt[196] = (bf16)(vw.x >> 16); vt[2 * 196] = (bf16)(vw.y & 0xffffu); vt[3 * 196] = (bf16)(vw.y >> 16);
        vt[4 * 196] = (bf16)(vw.z & 0xffffu); vt[5 * 196] = (bf16)(vw.z >> 16); vt[6 * 196] = (bf16)(vw.w & 0xffffu); vt[7 * 196] = (bf16)(vw.w >> 16);
    }
    __syncthreads();
    {
        const int hq = 4 * kvh + (F.wave >> 1);
        bf16* qrow = F.big + (size_t)(64 * cid + 32 * (F.wave & 1) + (F.lane & 31)) * PITCH + C_Q1 + 64 * hq;
        const int lo = sample ? 0 : (128 - 64 * cid);
        attn_core<64, 6, 72, 196>(Ks, Vs, qrow, 0.125f, F.inp(24)[hq], true, lo, F.lane);
    }
    __syncthreads();
}

struct SchedT {
    pg8::TileOrder T; const char* A; const char* B; size_t astep, bstep;
    __device__ bool next(int i, pg8::Unit& u) const {
        const long L = (long)i * T.G + T.c;
        if (!T.tile(L, u.pm, u.pn)) return false;
        u.kind = 0; u.A = A + (size_t)u.pm * astep; u.B = B + (size_t)u.pn * bstep; return true;
    }
};
template <bool FROM_INPUT, bool WRITE_XB>
struct EpiRes {
    static constexpr bool PERM = false;
    const float* xp; const float* xs; float* out; bf16* big; float* rss;
    __device__ __forceinline__ void operator()(const f32x4 (&acc)[2][2][4][2], const pg8::Unit& u, int wr, int wc, int fr, int fq) const {
        asm volatile("" : "+v"(fr), "+v"(fq));
        const int row0 = u.pm * 256 + wr * 64 + fr, col0 = u.pn * 256 + wc * 32 + 4 * fq;
#pragma unroll
        for (int ai = 0; ai < 2; ++ai)
#pragma unroll
            for (int m = 0; m < 4; ++m) {
                const int row = row0 + ai * 128 + m * 16;
                const float* base = FROM_INPUT ? (row < SEQ ? xp + (size_t)row * D : xs + (size_t)(row - SEQ) * D) : out + (size_t)row * D;
                float* o = out + (size_t)row * D; float ss = 0.f;
#pragma unroll
                for (int bj = 0; bj < 2; ++bj)
#pragma unroll
                    for (int n = 0; n < 2; ++n) {
                        const int c = col0 + bj * 128 + n * 16;
                        const f32x4 x = *(const f32x4*)(base + c) + acc[ai][bj][m][n];
                        *(f32x4*)(o + c) = x;
                        if (WRITE_XB) { *(u32x2*)(big + (size_t)row * PITCH + C_XB + c) = (u32x2){pk2(x.x, x.y), pk2(x.z, x.w)}; ss += (x.x * x.x + x.y * x.y) + (x.z * x.z + x.w * x.w); }
                    }
                if (WRITE_XB) { ss += __shfl_xor(ss, 16); ss += __shfl_xor(ss, 32); if (fq == 0) atomicAdd(rss + row, ss); }
                asm volatile("" ::: "memory");
            }
    }
};
struct EpiSwiglu {
    static constexpr bool PERM = true;
    bf16* big; const float* rss;
    __device__ __forceinline__ void operator()(const f32x4 (&acc)[2][2][4][2], const pg8::Unit& u, int wr, int wc, int fr, int fq) const {
        asm volatile("" : "+v"(fr), "+v"(fq));
        const int row0 = u.pm * 256 + wr * 64 + fr, col = C_ACT + u.pn * 128 + wc * 32 + 8 * fq;
#pragma unroll
        for (int ai = 0; ai < 2; ++ai)
#pragma unroll
            for (int m = 0; m < 4; ++m) {
                const int row = row0 + ai * 128 + m * 16;
                const float inv = 1.0f / sqrtf(rss[row] * (1.0f / 1024.0f) + EPS);
                float a[8];
#pragma unroll
                for (int n = 0; n < 2; ++n)
#pragma unroll
                    for (int j = 0; j < 4; ++j) { const float g = acc[ai][0][m][n][j] * inv, up = acc[ai][1][m][n][j] * inv; a[4 * n + j] = silu_f(g) * up; }
                *(u32x4*)(big + (size_t)row * PITCH + col) = (u32x4){pk2(a[0], a[1]), pk2(a[2], a[3]), pk2(a[4], a[5]), pk2(a[6], a[7])};
            }
    }
};
struct EpiScale {
    static constexpr bool PERM = true;
    bf16* big; const float* rss; int colbase;
    __device__ __forceinline__ void operator()(const f32x4 (&acc)[2][2][4][2], const pg8::Unit& u, int wr, int wc, int fr, int fq) const {
        asm volatile("" : "+v"(fr), "+v"(fq));
        const int row0 = u.pm * 256 + wr * 64 + fr, col = colbase + u.pn * 256 + wc * 32 + 8 * fq;
#pragma unroll
        for (int ai = 0; ai < 2; ++ai)
#pragma unroll
            for (int m = 0; m < 4; ++m) {
                const int row = row0 + ai * 128 + m * 16;
                const float inv = 1.0f / sqrtf(rss[row] * (1.0f / 1024.0f) + EPS);
#pragma unroll
                for (int bj = 0; bj < 2; ++bj) {
                    const f32x4 v0 = acc[ai][bj][m][0] * inv, v1 = acc[ai][bj][m][1] * inv;
                    *(u32x4*)(big + (size_t)row * PITCH + col + bj * 128) = (u32x4){pk2(v0[0], v0[1]), pk2(v0[2], v0[3]), pk2(v1[0], v1[1]), pk2(v1[2], v1[3])};
                }
            }
    }
};
template <class Epi>
__device__ __forceinline__ void run_gemm(Frame& F, int nN, int K, int acol, size_t wofs, const Epi& E) {
    SchedT S; S.T.init(66, nN, F.G, F.bid); S.A = (const char*)(F.big + acol); S.B = (const char*)(F.ws + wofs); S.astep = (size_t)256 * PITCH * 2; S.bstep = (size_t)256 * K * 2;
    pg8::gemm_phase<Epi, SchedT>(F.lds, F.tid, K, PITCH, S, E);
}

__global__ void __launch_bounds__(512, 2) mega_fwd(Args args) {
    extern __shared__ __attribute__((aligned(16))) unsigned char lds_raw[];
    Frame F;
    F.lds = (LAS unsigned char*)lds_raw;
    F.tid = threadIdx.x; F.lane = F.tid & 63; F.wave = __builtin_amdgcn_readfirstlane(F.tid >> 6);
    F.G = gridDim.x; F.bid = blockIdx.x;
    F.ka = (const float* const*)__builtin_amdgcn_kernarg_segment_ptr(); F.out = args.out; F.ws = args.ws;
    F.ctl = (gu32*)(args.ws + WS_CTL);
    F.big = (bf16*)(args.ws + WS_BIG);
    volatile LAS unsigned* MISC = (volatile LAS unsigned*)(F.lds + MISC_OFF);
    if (F.tid < 64) MISC[F.tid] = 0u;
    __syncthreads();
    XcdBarrier bar = xcd_barrier_post((unsigned*)(F.ctl + CW_BAR), MISC + 8);
    unsigned long long t_probe0 = 0, t_probe1 = 0; int phase_no = 0;
#define GRID_BAR() do { xcd_barrier(bar); PHASE_FENCE(); ++phase_no; if (PROBE_A >= 0) { if (phase_no == PROBE_A) t_probe0 = __builtin_amdgcn_s_memrealtime(); if (phase_no == PROBE_A + 1) t_probe1 = __builtin_amdgcn_s_memrealtime(); } } while (0)

    p0_prologue(F);
    GRID_BAR();
    if (LAST_PHASE < 1) return;
    {
        SchedP1 S; S.T.init(66, 19, F.G, F.bid); S.A = (const char*)F.out; S.B = (const char*)(F.ws + WS_WA); S.Amem = (const char*)(F.ws + WS_MEMB); S.Bmem = (const char*)(F.ws + WS_WMEM);
        EpiP1 E{F.big, (bf16*)(F.ws + WS_HALO), (float*)(F.ws + WS_BA), (const float*)(F.ws + WS_ROWSS0), (float*)(F.ws + WS_KVRAW), F.out};
        pg8::gemm_phase<EpiP1, SchedP1>(F.lds, F.tid, 1024, 1024, S, E);
    }
    GRID_BAR();
    if (LAST_PHASE < 2) return;
    fix_items(F, F.bid * 8 + F.wave, F.G * 8);
    for (int u = F.bid; u < NCH * 4; u += F.G) prep_unit(F, u >> 2, u & 3);
    GRID_BAR();
    if (LAST_PHASE < 3) return;
    for (int t = F.bid; t < 256; t += F.G) gdn_l1(F, t >> 3, t & 7);
    GRID_BAR();
    if (F.bid < 8) gdn_l2(F, F.bid, F.out + O_STATE_P + (size_t)F.bid * 16384);
    else if (F.bid < 72) { const int t = F.bid - 8, b = t >> 3, h = t & 7; gdn_scan(F, 256 + b, 1, h, F.inp(5) + (size_t)(b * 8 + h) * 16384, F.out + O_STATE_S + (size_t)(b * 8 + h) * 16384); }
    else for (int u = F.bid - 72; u < 288; u += F.G - 72) mem_attn_unit(F, 0, u, C_QM0);
    GRID_BAR();
    for (int t = F.bid; t < 256; t += F.G) { const int g = t >> 3, h = t & 7; gdn_scan(F, 8 * g, 8, h, g ? (const float*)(F.ws + WS_HSLOT) + ((size_t)(g - 1) * 8 + h) * 16384 : nullptr, nullptr); }
    GRID_BAR();
    if (LAST_PHASE < 4) return;
    float* rss1 = (float*)(F.ctl + CW_RSS1); float* rss2 = (float*)(F.ctl + CW_RSS2); float* rss3 = (float*)(F.ctl + CW_RSS3);
    { EpiRes<true, true> E{F.inp(0), F.inp(1), F.out, F.big, rss1}; run_gemm(F, 4, 1536, C_Z, WS_WOA, E); }
    GRID_BAR();
    { EpiSwiglu E{F.big, rss1}; run_gemm(F, 22, 1024, C_XB, WS_WGU0, E); }
    GRID_BAR();
    { EpiRes<false, true> E{nullptr, nullptr, F.out, F.big, rss2}; run_gemm(F, 4, 2816, C_ACT, WS_WD0, E); }
    GRID_BAR();
    if (LAST_PHASE < 8) return;
    { EpiScale E{F.big, rss2, C_Q1}; run_gemm(F, 8, 1024, C_XB, WS_WB, E); }
    GRID_BAR();
    for (int u = F.bid; u < 1056 + 288; u += F.G) { if (u < 1056) swa_unit(F, u >> 2, u & 3); else mem_attn_unit(F, 1, u - 1056, C_QM1); }
    GRID_BAR();
    { EpiRes<false, true> E{nullptr, nullptr, F.out, F.big, rss3}; run_gemm(F, 4, 1536, C_Q1, WS_WOB, E); }
    GRID_BAR();
    { EpiSwiglu E{F.big, rss3}; run_gemm(F, 22, 1024, C_XB, WS_WGU1, E); }
    GRID_BAR();
    { EpiRes<false, false> E{nullptr, nullptr, F.out, F.big, nullptr}; run_gemm(F, 4, 2816, C_ACT, WS_WD1, E); }
    if (PROBE_A >= 0) { GRID_BAR(); if (F.bid == 0 && F.tid == 0) F.out[0] += (float)(t_probe1 - t_probe0) * 1e-4f; }
#ifdef DBG_ZERO
    {
        const size_t gt = (size_t)F.bid * 512 + F.tid, GT = (size_t)F.G * 512;
        for (size_t i = gt; i < O_STATE_P; i += GT) F.out[i] = 0.f;
        for (size_t i = O_KP + gt; i < O_MEMK; i += GT) F.out[i] = 0.f;
        for (size_t i = O_STATE_P + gt; i < O_CONV_P; i += GT) F.out[i] *= 3.f;
    }
#endif
}

extern "C" void kernel_launch(void* const* d_in, const int* in_sizes, int n_in, void* d_out, int out_size, void* d_ws, size_t ws_size, hipStream_t stream) {
    static int grid = 0;
    if (grid == 0) {
        int dev = 0, cus = 0, per_cu = 0;
        if (n_in != 28 || ws_size < WS_END) { fprintf(stderr, "kernel_launch: unexpected n_in %d / ws %zu\n", n_in, ws_size); grid = -1; return; }
        if (hipGetDevice(&dev) != hipSuccess || hipDeviceGetAttribute(&cus, hipDeviceAttributeMultiprocessorCount, dev) != hipSuccess) { grid = -1; return; }
        if (hipFuncSetAttribute((const void*)mega_fwd, hipFuncAttributeMaxDynamicSharedMemorySize, LDS_BYTES) != hipSuccess) { fprintf(stderr, "kernel_launch: hipFuncSetAttribute failed\n"); grid = -1; return; }
        if (hipOccupancyMaxActiveBlocksPerMultiprocessor(&per_cu, (const void*)mega_fwd, 512, LDS_BYTES) != hipSuccess || per_cu < 1) { fprintf(stderr, "kernel_launch: occupancy query says %d\n", per_cu); per_cu = 1; }
        (void)hipGetLastError();
        grid = cus;
    }
    if (grid < 0) return;
    (void)hipMemsetAsync((char*)d_ws + WS_CTL, 0, CTL_ZERO_BYTES, stream);
    Args a{};
    for (int i = 0; i < 28; ++i) a.in[i] = (const float*)d_in[i];
    a.out = (float*)d_out; a.ws = (unsigned char*)d_ws;
    hipLaunchKernelGGL(mega_fwd, dim3(grid), dim3(512), LDS_BYTES, stream, a);
}
```

```cpp
#include <hip/hip_runtime.h>
#include <cstdio>
#include <cstdint>

#define LAS __attribute__((address_space(3)))
#define GAS __attribute__((address_space(1)))
typedef unsigned short bf16;
typedef short bf16x8 __attribute__((ext_vector_type(8)));
typedef short s16x4 __attribute__((ext_vector_type(4)));
typedef float f32x4 __attribute__((ext_vector_type(4)));
typedef float f32x2 __attribute__((ext_vector_type(2)));
typedef float f32x16 __attribute__((ext_vector_type(16)));
typedef unsigned u32x4 __attribute__((ext_vector_type(4)));
typedef unsigned u32x2 __attribute__((ext_vector_type(2)));
typedef GAS unsigned gu32;

#ifndef PROBE_A
#define PROBE_A -1
#endif
#ifndef LAST_PHASE
#define LAST_PHASE 99
#endif

constexpr int D = 1024, SEQ = 16384, NTOK = 16896, NCH = 264  ;
constexpr int PITCH = 4608;
constexpr int DFF = 2816;
constexpr float EPS = 1e-6f;
constexpr int C_Z = 3072, C_QM0 = 4096;
constexpr int C_XB = 0, C_ACT = 1024, C_Q1 = 1024, C_QM1 = 2048, C_K1 = 2560, C_V1 = 2816;

constexpr size_t O_Y = 0, O_STATE_P = 17301504, O_CONV_P = 17432576, O_STATE_S = 17441792, O_CONV_S = 18490368, O_KP = 18564096, O_VP = 18596864,
                 O_KS = 18629632, O_VS = 18760704, O_MEMK = 18891776, O_MEMV = 19153920;

constexpr size_t MiB = 1u << 20;
constexpr size_t WS_CTL = 0, CTL_ZERO_BYTES = 1 * MiB;
constexpr size_t WS_ROWSS0 = 1 * MiB;
constexpr size_t WS_BA = 2 * MiB;
constexpr size_t WS_HALO = 4 * MiB;
constexpr size_t WS_KVRAW = 9 * MiB;
constexpr size_t WS_MEMB = 11 * MiB;
constexpr size_t WS_ACHUNK = 11 * MiB + 768 * 1024;
constexpr size_t WS_SWAC = 12 * MiB;
constexpr size_t WS_KVIMG = 13 * MiB;
constexpr size_t WS_MG = 22 * MiB;
constexpr size_t WS_HSLOT = 30 * MiB;
constexpr size_t WS_WA = 46 * MiB;
constexpr size_t WS_WOA = WS_WA + (size_t)4864 * 1024 * 2;
constexpr size_t WS_WGU0 = WS_WOA + (size_t)1024 * 1536 * 2;
constexpr size_t WS_WD0 = WS_WGU0 + (size_t)5632 * 1024 * 2;
constexpr size_t WS_WB = WS_WD0 + (size_t)1024 * 2816 * 2;
constexpr size_t WS_WOB = WS_WB + (size_t)2048 * 1024 * 2;
constexpr size_t WS_WGU1 = WS_WOB + (size_t)1024 * 1536 * 2;
constexpr size_t WS_WD1 = WS_WGU1 + (size_t)5632 * 1024 * 2;
constexpr size_t WS_WMEM = WS_WD1 + (size_t)1024 * 2816 * 2;
constexpr size_t WS_WEND = WS_WMEM + (size_t)2 * 1024 * 1024 * 2;
constexpr size_t WS_BIG = 103 * MiB;
constexpr size_t WS_END = WS_BIG + (size_t)NTOK * PITCH * 2;
static_assert(WS_WEND <= WS_BIG && WS_END <= 256 * MiB, "d_ws map");
constexpr int CW_BAR = 4096;
constexpr int CW_RSS1 = 65536, CW_RSS2 = CW_RSS1 + 16896, CW_RSS3 = CW_RSS2 + 16896;
static_assert((CW_RSS3 + 16896) * 4 <= (int)CTL_ZERO_BYTES, "ctl");
constexpr size_t QX_BYTES = 24576;

constexpr int RING_BYTES = 131072;
constexpr int MISC_OFF = 163328;
constexpr int LDS_BYTES = 163840;

#define RLX_AGENT __ATOMIC_RELAXED, __HIP_MEMORY_SCOPE_AGENT
#define LDS_WAIT() asm volatile("s_waitcnt lgkmcnt(0)" ::: "memory")
#define VM_WAIT() asm volatile("s_waitcnt vmcnt(0)" ::: "memory")
typedef __bf16 bf16x2_t __attribute__((ext_vector_type(2)));
__device__ __forceinline__ unsigned pk2(float lo, float hi) { f32x2 v = {lo, hi}; bf16x2_t b = __builtin_convertvector(v, bf16x2_t); return __builtin_bit_cast(unsigned, b); }
__device__ __forceinline__ float bf2f(unsigned short b) { return __uint_as_float((unsigned)b << 16); }
__device__ __forceinline__ float bflo(unsigned w) { return __uint_as_float(w << 16); }
__device__ __forceinline__ float bfhi(unsigned w) { return __uint_as_float(w & 0xffff0000u); }
__device__ __forceinline__ float wave_sum(float v) {
#pragma unroll
    for (int o = 1; o < 64; o <<= 1) v += __shfl_xor(v, o);
    return v;
}
__device__ __forceinline__ float fast_exp(float x) { return __builtin_amdgcn_exp2f(x * 1.4426950408889634f); }
__device__ __forceinline__ float silu_f(float x) { return x * __builtin_amdgcn_rcpf(1.0f + __expf(-x)); }

#define XB_TMO      128
#define XB_XCNT(j)  (256  + 64 * (j))
#define XB_XSUB(j)  (1280 + 64 * (j))
#define XB_XGEN(j)  (2304 + 64 * (j))
#define XB_TOP      3328
#define XB_TOPGEN   3392
#define XCD_BAR_WORDS 3456
#define XB_SPIN_CAP (1u << 22)
__device__ __forceinline__ unsigned xb_ld(unsigned* p)              { return __hip_atomic_load(p, __ATOMIC_RELAXED, __HIP_MEMORY_SCOPE_AGENT); }
__device__ __forceinline__ unsigned xb_add(unsigned* p, unsigned v) { return __hip_atomic_fetch_add(p, v, __ATOMIC_RELAXED, __HIP_MEMORY_SCOPE_AGENT); }
__device__ __forceinline__ unsigned xb_xcc_id() { return (unsigned)__builtin_amdgcn_s_getreg((3 << 11) | 20) & 0xFu; }
#define XB_SPIN(cond, bar) do { unsigned _sp = 0; while (cond) { __builtin_amdgcn_s_sleep(1); \
    if ((++_sp & 255u) == 0u) { if (xb_ld(&(bar)[XB_TMO])) break; if (_sp > XB_SPIN_CAP) { atomicAdd(&(bar)[XB_TMO], 1u); break; } } } } while (0)
struct XcdBarrier { unsigned* bar; unsigned x; volatile LAS unsigned* st; };
__device__ __forceinline__ XcdBarrier xcd_barrier_post(unsigned* bar, volatile LAS unsigned* st) {
    XcdBarrier b; b.bar = bar; b.x = xb_xcc_id(); b.st = st;
    if (threadIdx.x == 0) (void)xb_add(&bar[XB_XCNT(b.x)], 1u);
    return b;
}
__device__ __forceinline__ void xcd_barrier_complete(unsigned* bar, unsigned x, unsigned& nloc, unsigned& nx) {
    const unsigned G = gridDim.x * gridDim.y * gridDim.z;
    unsigned sum, cnt, mine, sp = 0u;
    for (;;) {
        sum = 0u; cnt = 0u; mine = 0u;
#pragma unroll
        for (unsigned j = 0; j < 16; ++j) { const unsigned c = xb_ld(&bar[XB_XCNT(j)]); sum += c; cnt += (c > 0u) ? 1u : 0u; mine = (j == x) ? c : mine; }
        if (sum == G) break;
        __builtin_amdgcn_s_sleep(1);
        if ((++sp & 255u) == 0u) { if (xb_ld(&bar[XB_TMO])) break; if (sp > XB_SPIN_CAP) { atomicAdd(&bar[XB_TMO], 1u); break; } }
    }
    nloc = mine > 0u ? mine : 1u; nx = cnt > 0u ? cnt : 1u;
}
__device__ __forceinline__ void xcd_barrier(const XcdBarrier& b) {
    asm volatile("s_waitcnt vmcnt(0)" ::: "memory");
    __syncthreads();
    if (threadIdx.x == 0) {
        unsigned* bar = b.bar;
        __builtin_amdgcn_s_waitcnt(0);
        unsigned nloc = b.st[0], nx = b.st[1];
        if (nloc == 0u) { xcd_barrier_complete(bar, b.x, nloc, nx); b.st[0] = nloc; b.st[1] = nx; }
        const unsigned old = xb_add(&bar[XB_XSUB(b.x)], 1u);
        const unsigned gen = old / nloc;
        if (old + 1u == (gen + 1u) * nloc) {
            __builtin_amdgcn_fence(__ATOMIC_RELEASE, "agent");
            asm volatile("s_waitcnt vmcnt(0)" ::: "memory");
            const unsigned og = xb_add(&bar[XB_TOP], 1u);
            const unsigned tg = og / nx;
            if (og + 1u == (tg + 1u) * nx) xb_add(&bar[XB_TOPGEN], 1u);
            else XB_SPIN(xb_ld(&bar[XB_TOPGEN]) == tg, bar);
            __builtin_amdgcn_fence(__ATOMIC_ACQUIRE, "agent");
            xb_add(&bar[XB_XGEN(b.x)], 1u);
            asm volatile("s_waitcnt vmcnt(0)" ::: "memory");
        } else {
            XB_SPIN(xb_ld(&bar[XB_XGEN(b.x)]) == gen, bar);
            __builtin_amdgcn_fence(__ATOMIC_ACQUIRE, "agent");
            asm volatile("s_waitcnt vmcnt(0)" ::: "memory");
        }
    }
    __syncthreads();
}

struct Args { const float* in[28]; float* out; unsigned char* ws; };
struct Frame {
    LAS unsigned char* lds;
    gu32* ctl;
    int tid, lane, wave, G, bid;
    const float* const* ka;
    float* out; unsigned char* ws;
    bf16* big;
    __device__ __forceinline__ const float* inp(int k) const { return ka[k]; }
};
#define PHASE_FENCE() do { int t_ = F.tid; asm volatile("" : "+v"(t_)); F.tid = t_; F.lane = t_ & 63; const float* const* k_ = F.ka; asm volatile("" : "+s"(k_)); F.ka = k_; } while (0)

namespace pg8 {
constexpr int BM = 256, BK = 64, HALF = 128, HTB = HALF * BK * 2, STAGE_BYTES = 8 * HTB, NXCD = 8, WGM = 8;
__host__ __device__ __forceinline__ int lds_byte(int r, int c) { const int st = (r >> 4) * 2 + (c >> 5), rr = r & 15, cc = c & 31, ob = rr * 64 + cc * 2; return st * 1024 + (ob ^ (((ob >> 9) & 1) << 5)); }
__host__ __device__ __forceinline__ void stage_rc(int b, int& R, int& C) { const int st = b / 1024, sb = b % 1024, swz = sb ^ (((sb >> 9) & 1) << 5); R = (st >> 1) * 16 + swz / 64; C = (st & 1) * 32 + (swz % 64) / 2; }
__host__ __device__ __forceinline__ int perm32(int rho) { const int n = rho >> 4, i = rho & 15; return 8 * (i >> 2) + 4 * n + (i & 3); }

struct Unit { int pm, pn, kind; const char* A; const char* B; };
struct TileOrder {
    int nM, nN, nwg, G, c;
    __device__ void init(int nM_, int nN_, int G_, int c_) { nM = nM_; nN = nN_; nwg = nM * nN; G = G_; c = c_; }
    __device__ bool tile(long L, int& pm, int& pn) const {
        if (L >= nwg) return false;
        int wgid = (int)L; { const int q = nwg / NXCD, r = nwg % NXCD, xcd = wgid % NXCD, off = wgid / NXCD; wgid = (xcd < r ? xcd * (q + 1) : r * (q + 1) + (xcd - r) * q) + off; }
        const int nig = WGM * nN, gid = wgid / nig, fm = gid * WGM, gsz = (nM - fm) < WGM ? (nM - fm) : WGM;
        pm = fm + ((wgid % nig) % gsz); pn = (wgid % nig) / gsz; return true;
    }
};

template <class Epi, class Sched>
__device__ __forceinline__ void gemm_phase(LAS unsigned char* lds, const int tid, const int K, const int lda, const Sched& S, const Epi& E) {
    const int wid = __builtin_amdgcn_readfirstlane(tid >> 6), lane = tid & 63, wr = wid >> 2, wc = wid & 3, fr = lane & 15, fq = lane >> 4;
    const int nt = K / BK;
    unsigned voffA[2], voffB[2];
#pragma unroll
    for (int i = 0; i < 2; ++i) { int R, C; stage_rc(tid * 16 + i * 8192, R, C); const int Rb = Epi::PERM ? ((R & ~31) + perm32(R & 31)) : R;
        voffA[i] = (unsigned)(R * lda + C) * 2u; voffB[i] = (unsigned)(Rb * K + C) * 2u; }
    const size_t kstep = (size_t)(BK * 2);
    const size_t hstepA = (size_t)HALF * lda * 2, hstepB = (size_t)HALF * K * 2;
    const unsigned ldsw = (unsigned)wid * 1024u;
    const int aoff = lds_byte(wr * 64 + fr, fq * 8), boff = lds_byte(wc * 32 + fr, fq * 8);
#define PG8_SA(b, h) (((b) * 2 + (h)) * HTB)
#define PG8_SB(b, h) ((4 + (b) * 2 + (h)) * HTB)
#define PG8_STAGE(bufoff, gbase, voff) do { _Pragma("unroll") for (int _i = 0; _i < 2; ++_i) \
        __builtin_amdgcn_global_load_lds((const unsigned*)((const char*)(gbase) + (voff)[_i]), (LAS unsigned*)(lds + (bufoff) + ldsw + _i * 8192), 16, 0, 0); } while (0)
#define PG8_LDA(dst, b, h) do { _Pragma("unroll") for (int m = 0; m < 4; ++m) _Pragma("unroll") for (int k = 0; k < 2; ++k) dst[m][k] = *(const LAS bf16x8*)(lds + PG8_SA(b, h) + aoff + m * 2048 + k * 1024); } while (0)
#define PG8_LDB(dst, b, h) do { _Pragma("unroll") for (int n = 0; n < 2; ++n) _Pragma("unroll") for (int k = 0; k < 2; ++k) dst[n][k] = *(const LAS bf16x8*)(lds + PG8_SB(b, h) + boff + n * 2048 + k * 1024); } while (0)
#define PG8_MMA(ai, bj, At, Bt) do { __builtin_amdgcn_s_setprio(1); _Pragma("unroll") for (int m = 0; m < 4; ++m) _Pragma("unroll") for (int n = 0; n < 2; ++n) _Pragma("unroll") for (int k = 0; k < 2; ++k) \
        acc[ai][bj][m][n] = __builtin_amdgcn_mfma_f32_16x16x32_bf16(Bt[n][k], At[m][k], acc[ai][bj][m][n], 0, 0, 0); __builtin_amdgcn_s_setprio(0); } while (0)
#define PG8_WAIT_V(n) asm volatile("s_waitcnt vmcnt(" #n ")" ::: "memory")
#define PG8_WAIT_L(n) asm volatile("s_waitcnt lgkmcnt(" #n ")" ::: "memory")
#define PG8_BAR __builtin_amdgcn_s_barrier()
#define PG8_SCHED __builtin_amdgcn_sched_barrier(0)
    Unit cur, nxt; int ui = 0;
    if (!S.next(0, cur)) return;
    f32x4 acc[2][2][4][2];
#pragma unroll
    for (int a = 0; a < 2; ++a)
#pragma unroll
        for (int b = 0; b < 2; ++b)
#pragma unroll
            for (int m = 0; m < 4; ++m)
#pragma unroll
                for (int n = 0; n < 2; ++n) acc[a][b][m][n] = (f32x4){0.f, 0.f, 0.f, 0.f};
    bf16x8 At[4][2], B0[2][2], B1[2][2];
    const char* cA = cur.A; const char* cB = cur.B;
    PG8_STAGE(PG8_SB(0, 0), cB, voffB); PG8_STAGE(PG8_SB(0, 1), cB + hstepB, voffB); PG8_STAGE(PG8_SA(0, 0), cA, voffA); PG8_STAGE(PG8_SA(0, 1), cA + hstepA, voffA);
    if (wr == 1) PG8_BAR;
    PG8_WAIT_V(2); PG8_BAR;
    PG8_STAGE(PG8_SB(1, 0), cB + kstep, voffB); PG8_STAGE(PG8_SA(1, 0), cA + kstep, voffA); PG8_STAGE(PG8_SB(1, 1), cB + hstepB + kstep, voffB);
    PG8_WAIT_V(6); PG8_BAR;
    for (;;) {
        const bool has_next = S.next(ui + 1, nxt);
        const char* nA = has_next ? nxt.A : cA; const char* nB = has_next ? nxt.B : cB;
        for (int t = 0; t < nt; t += 2) {
            const bool last = (t == nt - 2);
            const char* a1 = cA + (size_t)(t + 1) * kstep;
            const char* a2 = last ? nA : cA + (size_t)(t + 2) * kstep; const char* b2 = last ? nB : cB + (size_t)(t + 2) * kstep;
            const char* a3 = a2 + kstep; const char* b3 = b2 + kstep;
            PG8_LDB(B0, 0, 0); PG8_LDB(B1, 0, 1); PG8_SCHED; PG8_LDA(At, 0, 0); PG8_STAGE(PG8_SA(1, 1), a1 + hstepA, voffA);
            PG8_WAIT_V(8); PG8_WAIT_L(0); PG8_BAR; PG8_MMA(0, 0, At, B0); PG8_MMA(0, 1, At, B1); PG8_BAR; PG8_SCHED;
            PG8_LDA(At, 0, 1); PG8_STAGE(PG8_SB(0, 0), b2, voffB); PG8_STAGE(PG8_SB(0, 1), b2 + hstepB, voffB); PG8_STAGE(PG8_SA(0, 0), a2, voffA);
            PG8_WAIT_V(8); PG8_WAIT_L(0); PG8_BAR; PG8_MMA(1, 0, At, B0); PG8_MMA(1, 1, At, B1); PG8_BAR; PG8_SCHED;
            PG8_LDB(B0, 1, 0); PG8_LDB(B1, 1, 1); PG8_SCHED; PG8_LDA(At, 1, 0); PG8_STAGE(PG8_SA(0, 1), a2 + hstepA, voffA);
            PG8_WAIT_V(8); PG8_WAIT_L(0); PG8_BAR; PG8_MMA(0, 0, At, B0); PG8_MMA(0, 1, At, B1); PG8_BAR; PG8_SCHED;
            PG8_LDA(At, 1, 1); PG8_STAGE(PG8_SB(1, 0), b3, voffB); PG8_STAGE(PG8_SB(1, 1), b3 + hstepB, voffB); PG8_STAGE(PG8_SA(1, 0), a3, voffA);
            PG8_WAIT_V(8); PG8_WAIT_L(0); PG8_BAR; PG8_MMA(1, 0, At, B0); PG8_MMA(1, 1, At, B1); PG8_BAR; PG8_SCHED;
        }
        if (wr == 0) PG8_BAR;
        E(acc, cur, wr, wc, fr, fq);
        if (!has_next) break;
#pragma unroll
        for (int a = 0; a < 2; ++a)
#pragma unroll
            for (int b = 0; b < 2; ++b)
#pragma unroll
                for (int m = 0; m < 4; ++m)
#pragma unroll
                    for (int n = 0; n < 2; ++n) acc[a][b][m][n] = (f32x4){0.f, 0.f, 0.f, 0.f};
        cur = nxt; cA = nA; cB = nB; ++ui;
        if (wr == 1) PG8_BAR;
    }
    PG8_WAIT_V(0);
    PG8_BAR;
#undef PG8_SA
#undef PG8_SB
#undef PG8_STAGE
#undef PG8_LDA
#undef PG8_LDB
#undef PG8_MMA
#undef PG8_WAIT_V
#undef PG8_WAIT_L
#undef PG8_BAR
#undef PG8_SCHED
}
}

__device__ __forceinline__ void tr_item(const float* W, int ldw, bf16* WT, int K, int k0, int dst_row0, int src_col0, int nvalid, const float* gain, LAS float* scr, int lane) {
    const int n = lane & 31;
#pragma unroll 8
    for (int i = 0; i < 32; ++i) { const int kk = 2 * i + (lane >> 5);
        float v = (n < nvalid) ? W[(size_t)(k0 + kk) * ldw + src_col0 + n] : 0.f;
        if (gain) v *= gain[k0 + kk];
        scr[kk * 33 + n] = v; }
    LDS_WAIT(); asm volatile("" ::: "memory");
    const int c = lane & 7;
#pragma unroll
    for (int j = 0; j < 4; ++j) { const int nn = (lane >> 3) + 8 * j; const LAS float* s = scr + (8 * c) * 33 + nn;
        u32x4 o; o.x = pk2(s[0 * 33], s[1 * 33]); o.y = pk2(s[2 * 33], s[3 * 33]); o.z = pk2(s[4 * 33], s[5 * 33]); o.w = pk2(s[6 * 33], s[7 * 33]);
        *(GAS u32x4*)(WT + (size_t)(dst_row0 + nn) * K + k0 + 8 * c) = o; }
    LDS_WAIT(); asm volatile("" ::: "memory");
}
__device__ __forceinline__ void wt_item(Frame& F, int it, LAS float* scr) {
    const float* W; int ldw, K, nblk, map; bf16* dst; const float* gain;
    int r = it;
    if (r < 2432) { W = F.inp(15); ldw = 4624; K = 1024; nblk = 152; map = 1; dst = (bf16*)(F.ws + WS_WA); gain = F.inp(9); }
    else if ((r -= 2432) < 768) { W = F.inp(20); ldw = 1024; K = 1536; nblk = 32; map = 0; dst = (bf16*)(F.ws + WS_WOA); gain = nullptr; }
    else if ((r -= 768) < 2816) { W = F.inp(26); ldw = 5632; K = 1024; nblk = 176; map = 2; dst = (bf16*)(F.ws + WS_WGU0); gain = F.inp(10); }
    else if ((r -= 2816) < 1408) { W = F.inp(27); ldw = 1024; K = 2816; nblk = 32; map = 0; dst = (bf16*)(F.ws + WS_WD0); gain = nullptr; }
    else if ((r -= 1408) < 1024) { W = F.inp(21); ldw = 2048; K = 1024; nblk = 64; map = 3; dst = (bf16*)(F.ws + WS_WB); gain = F.inp(9) + 1024; }
    else if ((r -= 1024) < 768) { W = F.inp(25); ldw = 1024; K = 1536; nblk = 32; map = 0; dst = (bf16*)(F.ws + WS_WOB); gain = nullptr; }
    else if ((r -= 768) < 2816) { W = F.inp(26) + (size_t)1024 * 5632; ldw = 5632; K = 1024; nblk = 176; map = 2; dst = (bf16*)(F.ws + WS_WGU1); gain = F.inp(10) + 1024; }
    else if ((r -= 2816) < 1408) { W = F.inp(27) + (size_t)2816 * 1024; ldw = 1024; K = 2816; nblk = 32; map = 0; dst = (bf16*)(F.ws + WS_WD1); gain = nullptr; }
    else if ((r -= 1408) < 512) { W = F.inp(12); ldw = 1024; K = 1024; nblk = 32; map = 0; dst = (bf16*)(F.ws + WS_WMEM); gain = F.inp(11); }
    else { r -= 512; W = F.inp(12) + (size_t)1024 * 1024; ldw = 1024; K = 1024; nblk = 32; map = 0; dst = (bf16*)(F.ws + WS_WMEM) + (size_t)1024 * 1024; gain = F.inp(11) + 1024; }
    const int kb = r / nblk, nb = r % nblk;
    int src0 = 32 * nb, nv = 32;
    if (map == 1) { if (nb < 128) { src0 = 32 * nb; } else if (nb < 144) { src0 = 4112 + 32 * (nb - 128); } else if (nb == 144) { src0 = 4096; nv = 16; } else { src0 = 0; nv = 0; } }
    else if (map == 2) { const int pn = nb >> 3, w = nb & 7; src0 = (w < 4) ? (128 * pn + 32 * w) : (2816 + 128 * pn + 32 * (w - 4)); }
    else if (map == 3) { if (nb < 32) src0 = 32 * nb; else if (nb < 48) src0 = 1536 + 32 * (nb - 32); else src0 = 1024 + 32 * (nb - 48); }
    tr_item(W, ldw, dst, K, 64 * kb, 32 * nb, src0, nv, gain, scr, F.lane);
}
constexpr int N_WT_ITEMS = 14464;
__device__ __forceinline__ void row_to_bf16(const float* xrow, bf16* orow, float* ss, int lane) {
    const GAS f32x4* xr = (const GAS f32x4*)xrow + lane;
    f32x4 v[4]; float s = 0.f;
#pragma unroll
    for (int j = 0; j < 4; ++j) { v[j] = xr[64 * j]; s += (v[j].x * v[j].x + v[j].y * v[j].y) + (v[j].z * v[j].z + v[j].w * v[j].w); }
    s = wave_sum(s);
    GAS u32x2* o8 = (GAS u32x2*)orow + lane;
#pragma unroll
    for (int j = 0; j < 4; ++j) { u32x2 w; w.x = pk2(v[j].x, v[j].y); w.y = pk2(v[j].z, v[j].w); o8[64 * j] = w; }
    if (lane == 0) *ss = s;
}
__device__ __forceinline__ void p0_prologue(Frame& F) {
    LAS float* scr = (LAS float*)(F.lds + F.wave * 16384);
    const int gw = F.bid * 8 + F.wave, NGW = F.G * 8;
    for (int it = gw; it < N_WT_ITEMS; it += NGW) wt_item(F, it, scr);
    bf16* xb = (bf16*)F.out;
    float* rss0 = (float*)(F.ws + WS_ROWSS0);
    for (int m = gw; m < NTOK + 256; m += NGW) {
        if (m < SEQ) row_to_bf16(F.inp(0) + (size_t)m * D, xb + (size_t)m * D, rss0 + m, F.lane);
        else if (m < NTOK) row_to_bf16(F.inp(1) + (size_t)(m - SEQ) * D, xb + (size_t)m * D, rss0 + m, F.lane);
        else row_to_bf16(F.inp(2) + (size_t)(m - NTOK) * D, (bf16*)(F.ws + WS_MEMB) + (size_t)(m - NTOK) * D, rss0 + m, F.lane);
    }
}

struct SchedP1 {
    pg8::TileOrder T; const char* A; const char* B; const char* Amem; const char* Bmem;
    __device__ bool next(int i, pg8::Unit& u) const {
        const long L = (long)i * T.G + T.c;
        if (L < T.nwg) { T.tile(L, u.pm, u.pn); u.kind = 0; u.A = A + (size_t)u.pm * 256 * 1024 * 2; u.B = B + (size_t)u.pn * 256 * 1024 * 2; return true; }
        const int e = (int)(L - T.nwg); if (e >= 8) return false;
        u.pm = 0; u.pn = e; u.kind = 1; u.A = Amem; u.B = Bmem + (size_t)e * 256 * 1024 * 2; return true;
    }
};
struct EpiP1 {
    static constexpr bool PERM = true;
    bf16* big; bf16* halo; float* ba; const float* rss0; float* kvraw; float* out;
    __device__ __forceinline__ void operator()(const f32x4 (&acc)[2][2][4][2], const pg8::Unit& u, int wr, int wc, int fr, int fq) const {
        asm volatile("" : "+v"(fr), "+v"(fq));
        if (u.kind == 0) {
            const int row0 = u.pm * 256 + wr * 64 + fr, colb = u.pn * 256 + wc * 32 + 8 * fq;
#pragma unroll
            for (int ai = 0; ai < 2; ++ai)
#pragma unroll
                for (int m = 0; m < 4; ++m) {
                    const int row = row0 + ai * 128 + m * 16;
                    const float inv = 1.0f / sqrtf(rss0[row] * (1.0f / 1024.0f) + EPS);
#pragma unroll
                    for (int bj = 0; bj < 2; ++bj) {
                        const f32x4 v0 = acc[ai][bj][m][0] * inv, v1 = acc[ai][bj][m][1] * inv; const int col = colb + bj * 128;
                        if (u.pn < 18) {
                            u32x4 w; w.x = pk2(v0[0], v0[1]); w.y = pk2(v0[2], v0[3]); w.z = pk2(v1[0], v1[1]); w.w = pk2(v1[2], v1[3]);
                            *(u32x4*)(big + (size_t)row * PITCH + col) = w;
                            if (m == 3 && fr >= 13 && u.pn < 12) {
                                const int cid = row >> 6, j = fr - 13;
                                *(u32x4*)(halo + ((size_t)cid * 3 + j) * 3072 + col) = w;
                                if (cid >= 255) { float* o = (cid == 255) ? out + O_CONV_P + (size_t)j * 3072 + col : out + O_CONV_S + ((size_t)(cid - 256) * 3 + j) * 3072 + col;
                                    *(f32x4*)o = v0; *(f32x4*)(o + 4) = v1; }
                            }
                        } else if (bj == 0 && wc == 0 && fq < 2) {
                            float* o = ba + (size_t)row * 16 + 8 * fq; *(f32x4*)o = v0; *(f32x4*)(o + 4) = v1;
                        }
                    }
                }
        } else {
            const int layer = u.pn >> 2, pnn = u.pn & 3;
            const int row0 = wr * 64 + fr, colb = pnn * 256 + wc * 32 + 8 * fq;
#pragma unroll
            for (int ai = 0; ai < 2; ++ai)
#pragma unroll
                for (int m = 0; m < 4; ++m) {
                    const int row = row0 + ai * 128 + m * 16;
                    const float inv = 1.0f / sqrtf(rss0[NTOK + row] * (1.0f / 1024.0f) + EPS);
#pragma unroll
                    for (int bj = 0; bj < 2; ++bj) {
                        float* o = kvraw + ((size_t)layer * 256 + row) * 1024 + colb + bj * 128;
                        *(f32x4*)o = acc[ai][bj][m][0] * inv; *(f32x4*)(o + 4) = acc[ai][bj][m][1] * inv;
                    }
                }
        }
    }
};

__device__ __forceinline__ bf16* kimg_ptr(unsigned char* ws, int layer, int stream, int head) { return (bf16*)(ws + WS_KVIMG) + ((size_t)((layer * 9 + stream) * 4 + head)) * 65536; }
__device__ __forceinline__ bf16* vtimg_ptr(unsigned char* ws, int layer, int stream, int head) { return kimg_ptr(ws, layer, stream, head) + 32768; }
__device__ __forceinline__ void fix_items(Frame& F, int gw, int NGW) {
    const int lane = F.lane;
    for (int it = gw; it < 512; it += NGW) {
        const int layer = it >> 8, m = it & 255;
        const float* src = (const float*)(F.ws + WS_KVRAW) + ((size_t)layer * 256 + m) * 1024 + 16 * lane;
        f32x4 v[4];
#pragma unroll
        for (int j = 0; j < 4; ++j) v[j] = *(const f32x4*)(src + 4 * j);
        const int col = 16 * lane;
        if (col < 512) {
            float s = 0.f;
#pragma unroll
            for (int j = 0; j < 4; ++j) s += (v[j].x * v[j].x + v[j].y * v[j].y) + (v[j].z * v[j].z + v[j].w * v[j].w);
            s += __shfl_xor(s, 1); s += __shfl_xor(s, 2); s += __shfl_xor(s, 4);
            const float inv = 1.0f / sqrtf(s * (1.0f / 128.0f) + EPS);
            const int hd = col >> 7, d0 = col & 127;
            const float* kg = F.inp(14) + layer * 128 + d0; const float* qg = F.inp(13) + layer * 128 + d0;
            float* o = F.out + O_MEMK + ((size_t)layer * 256 + m) * 512 + col;
            bf16* ki = kimg_ptr(F.ws, layer, 0, hd) + (size_t)m * 128 + d0;
            unsigned pw[8];
#pragma unroll
            for (int j = 0; j < 4; ++j) { f32x4 g = *(const f32x4*)(kg + 4 * j), q = *(const f32x4*)(qg + 4 * j); f32x4 r = v[j] * inv * g; *(f32x4*)(o + 4 * j) = r; r = r * q; pw[2 * j] = pk2(r.x, r.y); pw[2 * j + 1] = pk2(r.z, r.w); }
            *(u32x4*)ki = (u32x4){pw[0], pw[1], pw[2], pw[3]}; *(u32x4*)(ki + 8) = (u32x4){pw[4], pw[5], pw[6], pw[7]};
        } else {
            const int c2 = col - 512, hd = c2 >> 7, d0 = c2 & 127;
            float* o = F.out + O_MEMV + ((size_t)layer * 256 + m) * 512 + c2;
            bf16* vt = vtimg_ptr(F.ws, layer, 0, hd);
#pragma unroll
            for (int j = 0; j < 4; ++j) { *(f32x4*)(o + 4 * j) = v[j];
#pragma unroll
                for (int e = 0; e < 4; ++e) vt[(size_t)(d0 + 4 * j + e) * 256 + m] = (bf16)(pk2(v[j][e], 0.f) & 0xffffu); }
        }
    }
    for (int it = gw; it < 4096; it += NGW) {
        const int layer = it >> 11, b = (it >> 8) & 7, m = it & 255;
        const size_t base = (((size_t)layer * 8 + b) * 256 + m) * 512 + 8 * lane;
        const int hd = (8 * lane) >> 7, d0 = (8 * lane) & 127;
        const f32x4 k0 = *(const f32x4*)(F.inp(3) + base), k1 = *(const f32x4*)(F.inp(3) + base + 4);
        const f32x4 v0 = *(const f32x4*)(F.inp(4) + base), v1 = *(const f32x4*)(F.inp(4) + base + 4);
        const float* qg = F.inp(13) + layer * 128 + d0; const f32x4 q0 = *(const f32x4*)qg, q1 = *(const f32x4*)(qg + 4);
        const f32x4 a = k0 * q0, c = k1 * q1;
        *(u32x4*)(kimg_ptr(F.ws, layer, 1 + b, hd) + (size_t)m * 128 + d0) = (u32x4){pk2(a.x, a.y), pk2(a.z, a.w), pk2(c.x, c.y), pk2(c.z, c.w)};
        bf16* vt = vtimg_ptr(F.ws, layer, 1 + b, hd);
#pragma unroll
        for (int e = 0; e < 4; ++e) { vt[(size_t)(d0 + e) * 256 + m] = (bf16)(pk2(v0[e], 0.f) & 0xffffu); vt[(size_t)(d0 + 4 + e) * 256 + m] = (bf16)(pk2(v1[e], 0.f) & 0xffffu); }
    }
    for (int it = gw; it < 1024; it += NGW) {
        const size_t base = (size_t)it * 256 + 4 * lane; const int d0 = (4 * lane) & 63;
        const f32x4 k = *(const f32x4*)(F.inp(7) + base), v = *(const f32x4*)(F.inp(8) + base), q = *(const f32x4*)(F.inp(22) + d0);
        const f32x4 a = k * q;
        bf16* ko = (bf16*)(F.ws + WS_SWAC) + base; bf16* vo = ko + 8 * 128 * 256;
        *(u32x2*)ko = (u32x2){pk2(a.x, a.y), pk2(a.z, a.w)}; *(u32x2*)vo = (u32x2){pk2(v.x, v.y), pk2(v.z, v.w)};
    }
}

constexpr int PREP_HALF = 77824;
constexpr int PR_KT = 0, PR_QT = 17408, PR_VB = 34816, PR_AM = 52224  , PR_BETA = 70464, PR_CUM = 70720, PR_GSC = 70976, PR_G = 71232, PR_CW = 71488  ;
static_assert(2 * PREP_HALF <= MISC_OFF && PR_AM + 18224 <= PR_BETA && PR_CW + 6144 <= PREP_HALF, "prep LDS");
__device__ __forceinline__ void conv8(const LAS bf16* rawp, const LAS float* wp, float (&o)[8]) {
#pragma unroll
    for (int e = 0; e < 8; ++e) o[e] = 0.f;
#pragma unroll
    for (int tap = 0; tap < 4; ++tap) {
        const u32x4 r = *(const LAS u32x4*)(rawp + tap * 136);
        const f32x4 w0 = *(const LAS f32x4*)(wp + tap * 384), w1 = *(const LAS f32x4*)(wp + tap * 384 + 4);
        o[0] += bflo(r.x) * w0.x; o[1] += bfhi(r.x) * w0.y; o[2] += bflo(r.y) * w0.z; o[3] += bfhi(r.y) * w0.w;
        o[4] += bflo(r.z) * w1.x; o[5] += bfhi(r.z) * w1.y; o[6] += bflo(r.w) * w1.z; o[7] += bfhi(r.w) * w1.w;
    }
#pragma unroll
    for (int e = 0; e < 8; ++e) o[e] = silu_f(o[e]);
}
__device__ __forceinline__ int crow32(int g, int hh) { return (g & 3) + 8 * (g >> 2) + 4 * hh; }
__device__ __forceinline__ bf16 f2b(float v) { return (bf16)(pk2(v, 0.f) & 0xffffu); }
__device__ __forceinline__ void prep_load_cw(Frame& F, int hp) {
    const int hw = F.wave >> 2, h = 2 * hp + hw, th = F.tid & 255;
    LAS float* cw = (LAS float*)(F.lds + hw * PREP_HALF + PR_CW);
    for (int p = th; p < 384; p += 256) { const int tap = p / 96, rem = p - tap * 96, part = rem >> 5, c4 = rem & 31;
        *(LAS f32x4*)(cw + tap * 384 + part * 128 + 4 * c4) = *(const f32x4*)(F.inp(16) + (size_t)tap * 3072 + part * 1024 + 128 * h + 4 * c4); }
}
__device__ __forceinline__ void prep_unit(Frame& F, int cid, int hp) {
    const int hw = F.wave >> 2, h = 2 * hp + hw, th = F.tid & 255, wv = F.wave & 3, lane = F.lane;
    LAS unsigned char* L = F.lds + hw * PREP_HALF;
    LAS bf16* raw = (LAS bf16*)(L + PR_AM);
    LAS bf16* kt = (LAS bf16*)(L + PR_KT); LAS bf16* qt = (LAS bf16*)(L + PR_QT); LAS bf16* vb = (LAS bf16*)(L + PR_VB);
    LAS float* Am = (LAS float*)(L + PR_AM);
    LAS float* beta = (LAS float*)(L + PR_BETA); LAS float* cum = (LAS float*)(L + PR_CUM); LAS float* gsc = (LAS float*)(L + PR_GSC);
    const LAS float* cwl = (const LAS float*)(L + PR_CW);
    bf16* bigrow = F.big + (size_t)cid * 64 * PITCH;
    if (th < 64) {
        const float* bap = (const float*)(F.ws + WS_BA) + ((size_t)cid * 64 + th) * 16;
        const float braw = bap[h], araw = bap[8 + h];
        const float x = araw + F.inp(18)[h];
        const float sp = (x > 20.f) ? x : log1pf(__expf(x));
        float c = -__expf(F.inp(17)[h]) * sp;
        const float bt = 1.0f / (1.0f + __expf(-braw));
#pragma unroll
        for (int o = 1; o < 64; o <<= 1) { const float t = __shfl_up(c, o); if (lane >= o) c += t; }
        beta[th] = bt; cum[th] = c; gsc[th] = bt * __expf(c);
    }
    const int i = th >> 2, seg = th & 3;
#pragma unroll 1
    for (int part = 0; part < 3; ++part) {
        const int colg = part * 1024 + 128 * h;
        {
            u32x4 v[4];
#pragma unroll
            for (int k = 0; k < 4; ++k) { const int p = th + 256 * k; v[k] = *(const u32x4*)(bigrow + (unsigned)((p >> 4) * PITCH + colg + 8 * (p & 15))); }
            if (th < 48) {
                const int j = th >> 4, col = colg + 8 * (th & 15); u32x4 hv;
                if (cid == 0) hv = (u32x4){0u, 0u, 0u, 0u};
                else if (cid < 256) hv = *(const u32x4*)((const bf16*)(F.ws + WS_HALO) + ((size_t)(cid - 1) * 3 + j) * 3072 + col);
                else { const float* sp = F.inp(6) + ((size_t)(cid - 256) * 3 + j) * 3072 + col; const f32x4 a = *(const f32x4*)sp, b = *(const f32x4*)(sp + 4);
                       hv = (u32x4){pk2(a.x, a.y), pk2(a.z, a.w), pk2(b.x, b.y), pk2(b.z, b.w)}; }
                *(LAS u32x4*)(raw + j * 136 + 8 * (th & 15)) = hv;
            }
#pragma unroll
            for (int k = 0; k < 4; ++k) { const int p = th + 256 * k; *(LAS u32x4*)(raw + ((p >> 4) + 3) * 136 + 8 * (p & 15)) = v[k]; }
        }
        __syncthreads();
        float xv[32];
#pragma unroll
        for (int g8 = 0; g8 < 4; ++g8) {
            float o[8];
            conv8(raw + i * 136 + seg * 32 + g8 * 8, cwl + part * 128 + seg * 32 + g8 * 8, o);
#pragma unroll
            for (int e = 0; e < 8; ++e) xv[g8 * 8 + e] = o[e];
            asm volatile("" ::: "memory");
        }
        float sc;
        if (part < 2) {
            float ss = 0.f;
#pragma unroll
            for (int e = 0; e < 32; ++e) ss += xv[e] * xv[e];
            ss += __shfl_xor(ss, 1); ss += __shfl_xor(ss, 2);
            sc = 1.0f / sqrtf(ss + EPS); if (part == 0) sc *= 0.08838834764831845f;
        } else sc = beta[i];
        LAS bf16* dst = (part == 0 ? qt : (part == 1 ? kt : vb)) + i * 136 + seg * 32;
#pragma unroll
        for (int g8 = 0; g8 < 4; ++g8)
            *(LAS u32x4*)(dst + g8 * 8) = (u32x4){pk2(xv[g8*8+0] * sc, xv[g8*8+1] * sc), pk2(xv[g8*8+2] * sc, xv[g8*8+3] * sc), pk2(xv[g8*8+4] * sc, xv[g8*8+5] * sc), pk2(xv[g8*8+6] * sc, xv[g8*8+7] * sc)};
        __syncthreads();
    }
    bf16* qx = (bf16*)F.out + (size_t)(cid * 8 + h) * 12288;
    {
        const int ti = wv >> 1, tj = wv & 1, r = lane & 31, hh = lane >> 5;
        f32x16 kk, qk;
#pragma unroll
        for (int g = 0; g < 16; ++g) { kk[g] = 0.f; qk[g] = 0.f; }
#pragma unroll
        for (int s = 0; s < 8; ++s) {
            const bf16x8 a = *(const LAS bf16x8*)(kt + (32 * ti + r) * 136 + 16 * s + 8 * hh);
            const bf16x8 q = *(const LAS bf16x8*)(qt + (32 * ti + r) * 136 + 16 * s + 8 * hh);
            const bf16x8 b = *(const LAS bf16x8*)(kt + (32 * tj + r) * 136 + 16 * s + 8 * hh);
            kk = __builtin_amdgcn_mfma_f32_32x32x16_bf16(a, b, kk, 0, 0, 0);
            qk = __builtin_amdgcn_mfma_f32_32x32x16_bf16(b, q, qk, 0, 0, 0);
        }
        {
            const int j = 32 * tj + r; const float cj = cum[j];
#pragma unroll
            for (int g = 0; g < 16; ++g) {
                int hh_ = hh; asm volatile("" : "+v"(hh_));
                const int ii = 32 * ti + crow32(g, hh_);
                const float dec = __expf(fminf(cum[ii] - cj, 0.f));
                Am[ii * 68 + j] = (ii > j) ? beta[ii] * kk[g] * dec : 0.f;
            }
        }
        {
            const int ii = 32 * ti + r; const float ci = cum[ii];
#pragma unroll
            for (int a4 = 0; a4 < 4; ++a4) {
                int hh_ = hh; asm volatile("" : "+v"(hh_));
                const int j0 = 32 * tj + 8 * a4 + 4 * hh_; float v[4];
#pragma unroll
                for (int e = 0; e < 4; ++e) { const int j = j0 + e; v[e] = (ii >= j) ? qk[4 * a4 + e] * __expf(fminf(ci - cum[j], 0.f)) : 0.f; }
                *(u32x2*)(qx + (unsigned)(8192 + ii * 64 + (((j0 >> 3) ^ ((ii >> 1) & 7)) << 3) + (j0 & 7))) = (u32x2){pk2(v[0], v[1]), pk2(v[2], v[3])};
            }
        }
    }
    {
        const float clast = cum[63];
        bf16* kbase = bigrow + 1024 + 128 * h;
#pragma unroll
        for (int pp = 0; pp < 4; ++pp) {
            const int p = th + 256 * pp, kk = p >> 3, c16 = p & 7;
            float v[8];
#pragma unroll
            for (int e = 0; e < 8; ++e) { const int ii = 8 * c16 + e; v[e] = bf2f(kt[ii * 136 + kk]) * __expf(clast - cum[ii]); }
            const int e0 = kk * 64 + ((c16 ^ ((kk >> 1) & 7)) << 3);
            *(u32x4*)(kbase + (unsigned)((e0 >> 7) * PITCH + (e0 & 127))) = (u32x4){pk2(v[0], v[1]), pk2(v[2], v[3]), pk2(v[4], v[5]), pk2(v[6], v[7])};
        }
#pragma unroll
        for (int pp = 0; pp < 4; ++pp) {
            const int p = th + 256 * pp, ii = p >> 4, c16 = p & 15;
            const u32x4 r = *(const LAS u32x4*)(qt + ii * 136 + 8 * c16); const float ec = __expf(cum[ii]);
            *(u32x4*)(qx + (unsigned)(ii * 128 + ((c16 ^ (ii & 15)) << 3))) = (u32x4){pk2(bflo(r.x) * ec, bfhi(r.x) * ec), pk2(bflo(r.y) * ec, bfhi(r.y) * ec), pk2(bflo(r.z) * ec, bfhi(r.z) * ec), pk2(bflo(r.w) * ec, bfhi(r.w) * ec)};
        }
        if (th == 0) ((float*)(F.ws + WS_ACHUNK))[cid * 8 + h] = __expf(clast);
    }
    {
        const int c = th;
        float sol[64];
        {
            const LAS bf16* rp = (c < 128) ? (vb + c) : (kt + (c - 128));
#pragma unroll
            for (int ii = 0; ii < 64; ++ii) { float v = bf2f(rp[ii * 136]); if (c >= 128) v *= gsc[ii]; sol[ii] = v; }
        }
        __syncthreads();
        LAS bf16* wblob = qt; LAS bf16* ublob = vb;
        const int w = c >> 4, col = c & 15, kk = c - 128;
#pragma unroll
        for (int ii = 0; ii < 64; ++ii) {
            float v0 = 0.f, v1 = 0.f, v2 = 0.f, v3 = 0.f;
#pragma unroll
            for (int j4 = 0; j4 < (ii + 3) / 4; ++j4) {
                const f32x4 a = *(const LAS f32x4*)(Am + ii * 68 + 4 * j4);
                v0 += a.x * sol[4 * j4];
                if (4 * j4 + 1 < ii) v1 += a.y * sol[4 * j4 + 1];
                if (4 * j4 + 2 < ii) v2 += a.z * sol[4 * j4 + 2];
                if (4 * j4 + 3 < ii) v3 += a.w * sol[4 * j4 + 3];
            }
            const float v = sol[ii] - ((v0 + v1) + (v2 + v3));
            sol[ii] = v;
            int kk_ = kk, col_ = col; asm volatile("" : "+v"(kk_), "+v"(col_));
            if (c >= 128) wblob[ii * 128 + ((((kk_ >> 3) ^ (ii & 15)) << 3) + (kk_ & 7))] = f2b(v);
            else if ((ii & 3) == 3) { const int t4 = ii >> 4, q = (ii >> 2) & 3; *(LAS u32x2*)(ublob + (((w * 4 + t4) * 4 + q) * 16 + col_) * 4) = (u32x2){pk2(sol[ii - 3], sol[ii - 2]), pk2(sol[ii - 1], sol[ii])}; }
            asm volatile("" ::: "memory");
        }
    }
    __syncthreads();
    {
        bf16* wbase = bigrow + 128 * h; bf16* vbase = bigrow + 2048 + 128 * h;
#pragma unroll
        for (int pp = 0; pp < 4; ++pp) {
            const int p = th + 256 * pp;
            *(u32x4*)(wbase + (unsigned)((p >> 4) * PITCH + 8 * (p & 15))) = *(const LAS u32x4*)(qt + 8 * p);
            *(u32x4*)(vbase + (unsigned)((p >> 4) * PITCH + 8 * (p & 15))) = *(const LAS u32x4*)(vb + 8 * p);
        }
    }
    __syncthreads();
}

constexpr int EN_STAGE = 57344, EN_W = 0, EN_KDT = 16384, EN_QD = 32768, EN_QK = 49152, EN_SSQ = 2 * EN_STAGE, EN_TILE = EN_SSQ + 512;
static_assert(EN_TILE + 2 * 16384 <= MISC_OFF, "engine LDS");
__device__ __forceinline__ void en_stage(Frame& F, int cid, int h, int st) {
    const bf16* big = F.big; const int lane = F.lane;
#pragma unroll
    for (int k = 0; k < 7; ++k) {
        const int piece = F.wave + 8 * k;
        const char* g;
        if (piece < 32) { const int o = (piece & 15) * 1024 + lane * 16; g = (const char*)(big + ((size_t)cid * 64 + (o >> 8)) * PITCH + (piece < 16 ? 0 : 1024) + 128 * h) + (o & 255); }
        else g = (const char*)((const bf16*)F.out + (size_t)(cid * 8 + h) * 12288) + (piece - 32) * 1024 + lane * 16;
        __builtin_amdgcn_global_load_lds((const unsigned*)g, (LAS unsigned*)(F.lds + st * EN_STAGE + piece * 1024), 16, 0, 0);
    }
}
__device__ __forceinline__ void en_ztile(Frame& F, int cid, int h, int tb) {
#pragma unroll
    for (int k = 0; k < 2; ++k) { const int piece = F.wave + 8 * k; const int o = piece * 1024 + F.lane * 16;
        const char* g = (const char*)(F.big + ((size_t)cid * 64 + (o >> 8)) * PITCH + C_Z + 128 * h) + (o & 255);
        __builtin_amdgcn_global_load_lds((const unsigned*)g, (LAS unsigned*)(F.lds + EN_TILE + tb * 16384 + piece * 1024), 16, 0, 0); }
}
__device__ __forceinline__ bf16x8 pack2(const f32x4& a, const f32x4& b) { u32x4 p = {pk2(a.x, a.y), pk2(a.z, a.w), pk2(b.x, b.y), pk2(b.z, b.w)}; return __builtin_bit_cast(bf16x8, p); }
__device__ __forceinline__ bf16x8 ld_frag(const LAS unsigned char* p0, const LAS unsigned char* p1) { const u32x2 a = *(const LAS u32x2*)p0, b = *(const LAS u32x2*)p1; u32x4 p = {a.x, a.y, b.x, b.y}; return __builtin_bit_cast(bf16x8, p); }
#define MFMA16(a, b, c) __builtin_amdgcn_mfma_f32_16x16x32_bf16((a), (b), (c), 0, 0, 0)
__device__ __forceinline__ void gdn_scan(Frame& F, int cid0, int n, int h, const float* hinit, bool hinit_blob, float* hfinal) {
    const int w = F.wave; int lane = F.lane, col = lane & 15, q = lane >> 4;
    bf16* big = F.big;
    LAS float* ssq = (LAS float*)(F.lds + EN_SSQ);
    f32x4 hS[8];
#pragma unroll
    for (int t = 0; t < 8; ++t) {
        if (hinit && hinit_blob) hS[t] = *(const f32x4*)(hinit + w * 2048 + ((t * 4 + q) * 16 + col) * 4);
        else if (hinit) { const float* p = hinit + (size_t)(16 * t + 4 * q) * 128 + 16 * w + col; hS[t] = (f32x4){p[0], p[128], p[256], p[384]}; }
        else hS[t] = (f32x4){0.f, 0.f, 0.f, 0.f};
    }
    if (F.tid < 128) ssq[F.tid] = 0.f;
    const float og = F.inp(19)[16 * w + col];
    u32x2 un[4];
    en_stage(F, cid0, h, 0); en_ztile(F, cid0, h, 0);
#pragma unroll
    for (int t4 = 0; t4 < 4; ++t4) { const int e = (((w * 4 + t4) * 4 + q) * 16 + col) * 4; un[t4] = *(const u32x2*)(big + ((size_t)cid0 * 64 + (e >> 7)) * PITCH + 2048 + 128 * h + (e & 127)); }
    for (int s = 0; s < n; ++s) {
        const int cid = cid0 + s, st = s & 1;
        asm volatile("" : "+v"(lane)); col = lane & 15; q = lane >> 4;
        const int b128 = col * 256 + (q & 1) * 8 + (((q >> 1) ^ col) << 4), b64 = col * 128 + (q & 1) * 8 + (((q >> 1) ^ ((col >> 1) & 7)) << 4);
        VM_WAIT(); __syncthreads();
        if (s > 0) {
            const LAS bf16* tp = (const LAS bf16*)(F.lds + EN_TILE + (st ^ 1) * 16384);
#pragma unroll
            for (int k = 0; k < 2; ++k) { const int p = F.tid + 512 * k; *(u32x4*)(big + ((size_t)(cid - 1) * 64 + (p >> 4)) * PITCH + C_Z + 128 * h + 8 * (p & 15)) = *(const LAS u32x4*)(tp + 8 * p); }
        }
        f32x4 u[4];
#pragma unroll
        for (int t4 = 0; t4 < 4; ++t4) u[t4] = (f32x4){bflo(un[t4].x), bfhi(un[t4].x), bflo(un[t4].y), bfhi(un[t4].y)};
        if (s + 1 < n) {
            en_stage(F, cid + 1, h, st ^ 1);
#pragma unroll
            for (int t4 = 0; t4 < 4; ++t4) { const int e = (((w * 4 + t4) * 4 + q) * 16 + col) * 4; un[t4] = *(const u32x2*)(big + ((size_t)(cid + 1) * 64 + (e >> 7)) * PITCH + 2048 + 128 * h + (e & 127)); }
        }
        if (F.tid < 64) ssq[(st ^ 1) * 64 + F.tid] = 0.f;
        const LAS unsigned char* SB = F.lds + st * EN_STAGE;
        const float ach = ((const float*)(F.ws + WS_ACHUNK))[cid * 8 + h];
        bf16x8 hB[4];
#pragma unroll
        for (int ks = 0; ks < 4; ++ks) hB[ks] = pack2(hS[2 * ks], hS[2 * ks + 1]);
        f32x4 vn[4], o[4];
#pragma unroll
        for (int t4 = 0; t4 < 4; ++t4) {
            const int row = 16 * t4 + col; f32x4 a = {0.f, 0.f, 0.f, 0.f}, b = {0.f, 0.f, 0.f, 0.f};
#pragma unroll
            for (int ks = 0; ks < 4; ++ks) {
                const int off0 = (b128 ^ ((4 * ks) << 4)) + (row >> 4) * 4096, off1 = (b128 ^ ((4 * ks + 2) << 4)) + (row >> 4) * 4096;
                a = MFMA16(ld_frag(SB + EN_W + off0, SB + EN_W + off1), hB[ks], a);
                b = MFMA16(ld_frag(SB + EN_QD + off0, SB + EN_QD + off1), hB[ks], b);
            }
            vn[t4] = u[t4] - a; o[t4] = b;
        }
        bf16x8 vB[2];
        vB[0] = pack2(vn[0], vn[1]); vB[1] = pack2(vn[2], vn[3]);
#pragma unroll
        for (int t4 = 0; t4 < 4; ++t4) {
            const int row = 16 * t4 + col;
#pragma unroll
            for (int cs = 0; cs < 2; ++cs) {
                if (32 * cs > 16 * t4 + 15) continue;
                const int off0 = (b64 ^ ((4 * cs) << 4)) + (row >> 4) * 2048, off1 = (b64 ^ ((4 * cs + 2) << 4)) + (row >> 4) * 2048;
                o[t4] = MFMA16(ld_frag(SB + EN_QK + off0, SB + EN_QK + off1), vB[cs], o[t4]);
            }
        }
#pragma unroll
        for (int t = 0; t < 8; ++t) {
            const int row = 16 * t + col; f32x4 a = hS[t] * ach;
#pragma unroll
            for (int cs = 0; cs < 2; ++cs) {
                const int off0 = (b64 ^ ((4 * cs) << 4)) + (row >> 4) * 2048, off1 = (b64 ^ ((4 * cs + 2) << 4)) + (row >> 4) * 2048;
                a = MFMA16(ld_frag(SB + EN_KDT + off0, SB + EN_KDT + off1), vB[cs], a);
            }
            hS[t] = a;
        }
#pragma unroll
        for (int t4 = 0; t4 < 4; ++t4)
#pragma unroll
            for (int r = 0; r < 4; ++r) {
                float v = o[t4][r] * o[t4][r];
                v += __shfl_xor(v, 1); v += __shfl_xor(v, 2); v += __shfl_xor(v, 4); v += __shfl_xor(v, 8);
                if (col == 0) atomicAdd((float*)(ssq + st * 64 + 16 * t4 + 4 * q + r), v);
            }
        LAS bf16* tile = (LAS bf16*)(F.lds + EN_TILE + st * 16384);
        __syncthreads();
        if (s + 1 < n) en_ztile(F, cid + 1, h, st ^ 1);
#pragma unroll
        for (int t4 = 0; t4 < 4; ++t4)
#pragma unroll
            for (int r = 0; r < 4; ++r) {
                const int row = 16 * t4 + 4 * q + r;
                const float inv = 1.0f / sqrtf(ssq[st * 64 + row] * (1.0f / 128.0f) + EPS);
                LAS bf16* zp = tile + row * 128 + 16 * w + col;
                const float z = bf2f(*zp);
                *zp = f2b(o[t4][r] * inv * og * silu_f(z));
            }
    }
    __syncthreads();
    {
        const LAS bf16* tp = (const LAS bf16*)(F.lds + EN_TILE + ((n - 1) & 1) * 16384);
#pragma unroll
        for (int k = 0; k < 2; ++k) { const int p = F.tid + 512 * k; *(u32x4*)(big + ((size_t)(cid0 + n - 1) * 64 + (p >> 4)) * PITCH + C_Z + 128 * h + 8 * (p & 15)) = *(const LAS u32x4*)(tp + 8 * p); }
    }
    if (hfinal) {
#pragma unroll
        for (int t = 0; t < 8; ++t) { float* p = hfinal + (size_t)(16 * t + 4 * q) * 128 + 16 * w + col; p[0] = hS[t].x; p[128] = hS[t].y; p[256] = hS[t].z; p[384] = hS[t].w; }
    }
    __syncthreads();
}

__device__ __forceinline__ void en_stage1(Frame& F, int cid, int h, int st) {
    const bf16* big = F.big; const int lane = F.lane;
#pragma unroll
    for (int k = 0; k < 4; ++k) {
        const int piece = F.wave + 8 * k; const int o = (piece & 15) * 1024 + lane * 16;
        const char* g = (const char*)(big + ((size_t)cid * 64 + (o >> 8)) * PITCH + (piece < 16 ? 0 : 1024) + 128 * h) + (o & 255);
        __builtin_amdgcn_global_load_lds((const unsigned*)g, (LAS unsigned*)(F.lds + st * 32768 + piece * 1024), 16, 0, 0);
    }
}
__device__ __forceinline__ void gdn_l1(Frame& F, int g, int h) {
    const int w = F.wave, lane = F.lane, col = lane & 15, q = lane >> 4, cid0 = 8 * g;
    const int b128 = col * 256 + (q & 1) * 8 + (((q >> 1) ^ col) << 4), b64 = col * 128 + (q & 1) * 8 + (((q >> 1) ^ ((col >> 1) & 7)) << 4);
    const bf16* big = F.big;
    f32x4 hB[8], hP[8];
#pragma unroll
    for (int t = 0; t < 8; ++t) { hB[t] = (f32x4){0.f, 0.f, 0.f, 0.f};
#pragma unroll
        for (int r = 0; r < 4; ++r) hP[t][r] = (16 * t + 4 * q + r == 16 * w + col) ? 1.f : 0.f; }
    u32x2 un[4];
    en_stage1(F, cid0, h, 0);
#pragma unroll
    for (int t4 = 0; t4 < 4; ++t4) { const int e = (((w * 4 + t4) * 4 + q) * 16 + col) * 4; un[t4] = *(const u32x2*)(big + ((size_t)cid0 * 64 + (e >> 7)) * PITCH + 2048 + 128 * h + (e & 127)); }
#pragma unroll 1
    for (int s = 0; s < 8; ++s) {
        const int cid = cid0 + s, st = s & 1;
        VM_WAIT(); __syncthreads();
        f32x4 u[4];
#pragma unroll
        for (int t4 = 0; t4 < 4; ++t4) u[t4] = (f32x4){bflo(un[t4].x), bfhi(un[t4].x), bflo(un[t4].y), bfhi(un[t4].y)};
        if (s + 1 < 8) {
            en_stage1(F, cid + 1, h, st ^ 1);
#pragma unroll
            for (int t4 = 0; t4 < 4; ++t4) { const int e = (((w * 4 + t4) * 4 + q) * 16 + col) * 4; un[t4] = *(const u32x2*)(big + ((size_t)(cid + 1) * 64 + (e >> 7)) * PITCH + 2048 + 128 * h + (e & 127)); }
        }
        const LAS unsigned char* SB = F.lds + st * 32768;
        const float ach = ((const float*)(F.ws + WS_ACHUNK))[cid * 8 + h];
        bf16x8 fB[4], fP[4];
#pragma unroll
        for (int ks = 0; ks < 4; ++ks) { fB[ks] = pack2(hB[2 * ks], hB[2 * ks + 1]); fP[ks] = pack2(hP[2 * ks], hP[2 * ks + 1]); }
        f32x4 vnB[4], vnP[4];
#pragma unroll
        for (int t4 = 0; t4 < 4; ++t4) {
            const int row = 16 * t4 + col; f32x4 a = {0.f, 0.f, 0.f, 0.f}, b = {0.f, 0.f, 0.f, 0.f};
#pragma unroll
            for (int ks = 0; ks < 4; ++ks) {
                const int off0 = (b128 ^ ((4 * ks) << 4)) + (row >> 4) * 4096, off1 = (b128 ^ ((4 * ks + 2) << 4)) + (row >> 4) * 4096;
                const bf16x8 wf = ld_frag(SB + off0, SB + off1);
                a = MFMA16(wf, fB[ks], a); b = MFMA16(wf, fP[ks], b);
            }
            vnB[t4] = u[t4] - a; vnP[t4] = -b;
            asm volatile("" ::: "memory");
        }
        bf16x8 vB[2], vP[2];
        vB[0] = pack2(vnB[0], vnB[1]); vB[1] = pack2(vnB[2], vnB[3]); vP[0] = pack2(vnP[0], vnP[1]); vP[1] = pack2(vnP[2], vnP[3]);
#pragma unroll
        for (int t = 0; t < 8; ++t) {
            const int row = 16 * t + col; f32x4 a = hB[t] * ach, b = hP[t] * ach;
#pragma unroll
            for (int cs = 0; cs < 2; ++cs) {
                const int off0 = (b64 ^ ((4 * cs) << 4)) + (row >> 4) * 2048, off1 = (b64 ^ ((4 * cs + 2) << 4)) + (row >> 4) * 2048;
                const bf16x8 kf = ld_frag(SB + 16384 + off0, SB + 16384 + off1);
                a = MFMA16(kf, vB[cs], a); b = MFMA16(kf, vP[cs], b);
            }
            hB[t] = a; hP[t] = b;
            asm volatile("" ::: "memory");
        }
    }
    float* hs = (float*)(F.ws + WS_HSLOT) + ((size_t)g * 8 + h) * 16384;
    bf16* mg = (bf16*)(F.ws + WS_MG) + ((size_t)g * 8 + h) * 16384;
#pragma unroll
    for (int t = 0; t < 8; ++t) {
        int q_ = q, col_ = col; asm volatile("" : "+v"(q_), "+v"(col_));
        *(f32x4*)(hs + (unsigned)(w * 2048 + ((t * 4 + q_) * 16 + col_) * 4)) = hB[t];
#pragma unroll
        for (int r = 0; r < 4; ++r) { const int i = 16 * t + 4 * q_ + r, kk = 16 * w + col_; mg[(unsigned)(i * 128 + ((((kk >> 3) ^ (i & 15)) << 3) + (kk & 7)))] = f2b(hP[t][r]); }
        asm volatile("" ::: "memory");
    }
    __syncthreads();
}
__device__ __forceinline__ void en_stage2(Frame& F, int g, int h, int st) {
    const char* src = (const char*)((const bf16*)(F.ws + WS_MG) + ((size_t)g * 8 + h) * 16384);
#pragma unroll
    for (int k = 0; k < 4; ++k) { const int piece = F.wave + 8 * k;
        __builtin_amdgcn_global_load_lds((const unsigned*)(src + piece * 1024 + F.lane * 16), (LAS unsigned*)(F.lds + st * 32768 + piece * 1024), 16, 0, 0); }
}
__device__ __forceinline__ void gdn_l2(Frame& F, int h, float* hfinal) {
    const int w = F.wave, lane = F.lane, col = lane & 15, q = lane >> 4;
    const int b128 = col * 256 + (q & 1) * 8 + (((q >> 1) ^ col) << 4);
    f32x4 hS[8], bn[8];
#pragma unroll
    for (int t = 0; t < 8; ++t) hS[t] = (f32x4){0.f, 0.f, 0.f, 0.f};
    en_stage2(F, 0, h, 0);
    {
        const float* hs = (const float*)(F.ws + WS_HSLOT) + (size_t)h * 16384;
#pragma unroll
        for (int t = 0; t < 8; ++t) bn[t] = *(const f32x4*)(hs + w * 2048 + ((t * 4 + q) * 16 + col) * 4);
    }
#pragma unroll 1
    for (int g = 0; g < 32; ++g) {
        const int st = g & 1;
        VM_WAIT(); __syncthreads();
        f32x4 acc[8];
#pragma unroll
        for (int t = 0; t < 8; ++t) acc[t] = bn[t];
        float* hs = (float*)(F.ws + WS_HSLOT) + ((size_t)g * 8 + h) * 16384;
        if (g + 1 < 32) {
            en_stage2(F, g + 1, h, st ^ 1);
            const float* hn = hs + 8 * 16384;
#pragma unroll
            for (int t = 0; t < 8; ++t) bn[t] = *(const f32x4*)(hn + w * 2048 + ((t * 4 + q) * 16 + col) * 4);
        }
        const LAS unsigned char* SB = F.lds + st * 32768;
        bf16x8 fB[4];
#pragma unroll
        for (int ks = 0; ks < 4; ++ks) fB[ks] = pack2(hS[2 * ks], hS[2 * ks + 1]);
#pragma unroll
        for (int t = 0; t < 8; ++t) {
            const int row = 16 * t + col; f32x4 a = acc[t];
#pragma unroll
            for (int ks = 0; ks < 4; ++ks) {
                const int off0 = (b128 ^ ((4 * ks) << 4)) + (row >> 4) * 4096, off1 = (b128 ^ ((4 * ks + 2) << 4)) + (row >> 4) * 4096;
                a = MFMA16(ld_frag(SB + off0, SB + off1), fB[ks], a);
            }
            hS[t] = a;
            *(f32x4*)(hs + w * 2048 + ((t * 4 + q) * 16 + col) * 4) = a;
        }
    }
#pragma unroll
    for (int t = 0; t < 8; ++t) { float* p = hfinal + (size_t)(16 * t + 4 * q) * 128 + 16 * w + col; p[0] = hS[t].x; p[128] = hS[t].y; p[256] = hS[t].z; p[384] = hS[t].w; }
    __syncthreads();
}

#define MFMA32(a, b, c) __builtin_amdgcn_mfma_f32_32x32x16_bf16((a), (b), (c), 0, 0, 0)
template <int HD, int NKT, int KP, int VP>
__device__ __forceinline__ void attn_core(const LAS bf16* Ks, const LAS bf16* Vs, bf16* qrow, float scale, float sink, bool has_sink, int lo, int lane) {
    const int r = lane & 31, hh = lane >> 5;
    constexpr int NS = HD / 16, NDT = HD / 32;
    bf16x8 qf[NS]; float ss = 0.f;
#pragma unroll
    for (int s = 0; s < NS; ++s) {
        const u32x4 v = *(const u32x4*)(qrow + 16 * s + 8 * hh); qf[s] = __builtin_bit_cast(bf16x8, v);
        ss += bflo(v.x) * bflo(v.x) + bfhi(v.x) * bfhi(v.x) + bflo(v.y) * bflo(v.y) + bfhi(v.y) * bfhi(v.y) + bflo(v.z) * bflo(v.z) + bfhi(v.z) * bfhi(v.z) + bflo(v.w) * bflo(v.w) + bfhi(v.w) * bfhi(v.w);
    }
    ss += __shfl_xor(ss, 32);
    const float inv = (1.0f / sqrtf(ss * (1.0f / HD) + EPS)) * scale;
    float m = -INFINITY;
#pragma unroll 1
    for (int kt = 0; kt < NKT; ++kt) {
        f32x16 acc;
#pragma unroll
        for (int g = 0; g < 16; ++g) acc[g] = 0.f;
#pragma unroll
        for (int s = 0; s < NS; ++s) acc = MFMA32(*(const LAS bf16x8*)(Ks + (32 * kt + r) * KP + 16 * s + 8 * hh), qf[s], acc);
#pragma unroll
        for (int g = 0; g < 16; ++g) { const int key = 32 * kt + crow32(g, hh); float v = acc[g] * inv; if (key < lo) v = -INFINITY; m = fmaxf(m, v); }
    }
    m = fmaxf(m, __shfl_xor(m, 32)); if (has_sink) m = fmaxf(m, sink);
    float l = 0.f;
    f32x16 O[NDT];
#pragma unroll
    for (int dt = 0; dt < NDT; ++dt)
#pragma unroll
        for (int g = 0; g < 16; ++g) O[dt][g] = 0.f;
#pragma unroll 1
    for (int kt = 0; kt < NKT; ++kt) {
        f32x16 acc;
#pragma unroll
        for (int g = 0; g < 16; ++g) acc[g] = 0.f;
#pragma unroll
        for (int s = 0; s < NS; ++s) acc = MFMA32(*(const LAS bf16x8*)(Ks + (32 * kt + r) * KP + 16 * s + 8 * hh), qf[s], acc);
#pragma unroll
        for (int g = 0; g < 16; ++g) { const int key = 32 * kt + crow32(g, hh); float v = acc[g] * inv; if (key < lo) v = -INFINITY; const float pe = __expf(v - m); acc[g] = pe; l += pe; }
#pragma unroll
        for (int st = 0; st < 2; ++st) {
            const u32x4 pw = {pk2(acc[8 * st], acc[8 * st + 1]), pk2(acc[8 * st + 2], acc[8 * st + 3]), pk2(acc[8 * st + 4], acc[8 * st + 5]), pk2(acc[8 * st + 6], acc[8 * st + 7])};
            const bf16x8 pf = __builtin_bit_cast(bf16x8, pw);
#pragma unroll
            for (int dt = 0; dt < NDT; ++dt) {
                const LAS bf16* vp = Vs + (32 * dt + r) * VP + 32 * kt + 16 * st + 4 * hh;
                O[dt] = MFMA32(ld_frag((const LAS unsigned char*)vp, (const LAS unsigned char*)(vp + 8)), pf, O[dt]);
            }
        }
    }
    l += __shfl_xor(l, 32); if (has_sink) l += __expf(sink - m);
    const float rl = 1.0f / l;
#pragma unroll
    for (int dt = 0; dt < NDT; ++dt)
#pragma unroll
        for (int a4 = 0; a4 < 4; ++a4)
            *(u32x2*)(qrow + 32 * dt + 8 * a4 + 4 * hh) = (u32x2){pk2(O[dt][4 * a4] * rl, O[dt][4 * a4 + 1] * rl), pk2(O[dt][4 * a4 + 2] * rl, O[dt][4 * a4 + 3] * rl)};
}
__device__ __forceinline__ void mem_attn_unit(Frame& F, int layer, int u, int qcol) {
    const int hd = u & 3; int stream, row0, nrows;
    if (u < 256) { stream = 0; row0 = (u >> 2) * 256; nrows = 256; } else { const int b = (u - 256) >> 2; stream = 1 + b; row0 = SEQ + 64 * b; nrows = 64; }
    LAS bf16* Ks = (LAS bf16*)F.lds; LAS bf16* Vs = (LAS bf16*)(F.lds + 69632);
    const bf16* kg = kimg_ptr(F.ws, layer, stream, hd); const bf16* vg = kg + 32768;
    for (int p = F.tid; p < 4096; p += 512) { const int row = p >> 4, c = p & 15; *(LAS u32x4*)(Ks + row * 136 + 8 * c) = *(const u32x4*)(kg + row * 128 + 8 * c); }
    for (int p = F.tid; p < 4096; p += 512) { const int d = p >> 5, c = p & 31; const u32x4 v = *(const u32x4*)(vg + d * 256 + 8 * c);
        *(LAS u32x2*)(Vs + d * 260 + 8 * c) = (u32x2){v.x, v.y}; *(LAS u32x2*)(Vs + d * 260 + 8 * c + 4) = (u32x2){v.z, v.w}; }
    __syncthreads();
    if (32 * F.wave < nrows) {
        bf16* qrow = F.big + (size_t)(row0 + 32 * F.wave + (F.lane & 31)) * PITCH + qcol + 128 * hd;
        attn_core<128, 8, 136, 260>(Ks, Vs, qrow, 0.08838834764831845f, 0.f, false, 0, F.lane);
    }
    __syncthreads();
}
__device__ __forceinline__ void swa_unit(Frame& F, int cid, int kvh) {
    LAS bf16* Ks = (LAS bf16*)F.lds; LAS bf16* Vs = (LAS bf16*)(F.lds + 27648);
    const bool sample = cid >= 256; const int b = cid - 256;
    const float* kgain = F.inp(23); const float* qgain = F.inp(22);
    for (int p = F.tid; p < 1536; p += 512) {
        const int t = p >> 3, c8 = p & 7, d0 = 8 * c8;
        u32x4 kw = {0u, 0u, 0u, 0u}, vw = {0u, 0u, 0u, 0u};
        if (sample && t < 128) {
            const bf16* kc = (const bf16*)(F.ws + WS_SWAC) + ((size_t)b * 128 + t) * 256 + 64 * kvh + d0;
            kw = *(const u32x4*)kc; vw = *(const u32x4*)(kc + 8 * 128 * 256);
        } else {
            const int row = sample ? (SEQ + 64 * b + t - 128) : (64 * cid - 128 + t);
            float kf[8];
            if (row >= 0) { const bf16* src = F.big + (size_t)row * PITCH + C_K1 + 64 * kvh + d0; const u32x4 kr = *(const u32x4*)src; vw = *(const u32x4*)(src + 256);
                kf[0] = bflo(kr.x); kf[1] = bfhi(kr.x); kf[2] = bflo(kr.y); kf[3] = bfhi(kr.y); kf[4] = bflo(kr.z); kf[5] = bfhi(kr.z); kf[6] = bflo(kr.w); kf[7] = bfhi(kr.w); }
            else {
#pragma unroll
                for (int e = 0; e < 8; ++e) kf[e] = 0.f; }
            float ss = 0.f;
#pragma unroll
            for (int e = 0; e < 8; ++e) ss += kf[e] * kf[e];
            ss += __shfl_xor(ss, 1); ss += __shfl_xor(ss, 2); ss += __shfl_xor(ss, 4);
            const float inv = 1.0f / sqrtf(ss * (1.0f / 64.0f) + EPS);
            const f32x4 g0 = *(const f32x4*)(kgain + d0), g1 = *(const f32x4*)(kgain + d0 + 4), q0 = *(const f32x4*)(qgain + d0), q1 = *(const f32x4*)(qgain + d0 + 4);
            float kn[8] = {kf[0] * inv * g0.x, kf[1] * inv * g0.y, kf[2] * inv * g0.z, kf[3] * inv * g0.w, kf[4] * inv * g1.x, kf[5] * inv * g1.y, kf[6] * inv * g1.z, kf[7] * inv * g1.w};
            if (t >= 128 && (sample || cid >= 254)) {
                const size_t o = sample ? ((size_t)((b * 64 + (t - 128)) * 4 + kvh) * 64 + d0) : ((size_t)((row - (SEQ - 128)) * 4 + kvh) * 64 + d0);
                float* ko = F.out + (sample ? O_KS : O_KP) + o; float* vo = F.out + (sample ? O_VS : O_VP) + o;
                *(f32x4*)ko = (f32x4){kn[0], kn[1], kn[2], kn[3]}; *(f32x4*)(ko + 4) = (f32x4){kn[4], kn[5], kn[6], kn[7]};
                *(f32x4*)vo = (f32x4){bflo(vw.x), bfhi(vw.x), bflo(vw.y), bfhi(vw.y)}; *(f32x4*)(vo + 4) = (f32x4){bflo(vw.z), bfhi(vw.z), bflo(vw.w), bfhi(vw.w)};
            }
            kw = (u32x4){pk2(kn[0] * q0.x, kn[1] * q0.y), pk2(kn[2] * q0.z, kn[3] * q0.w), pk2(kn[4] * q1.x, kn[5] * q1.y), pk2(kn[6] * q1.z, kn[7] * q1.w)};
        }
        *(LAS u32x4*)(Ks + t * 72 + d0) = kw;
        LAS bf16* vt = Vs + d0 * 196 + t;
        vt[0] = (bf16)(vw.x & 0xffffu); vt[196] = (bf16)(vw.x >> 16); vt[2 * 196] = (bf16)(vw.y & 0xffffu); vt[3 * 196] = (bf16)(vw.y >> 16);
        vt[4 * 196] = (bf16)(vw.z & 0xffffu); vt[5 * 196] = (bf16)(vw.z >> 16); vt[6 * 196] = (bf16)(vw.w & 0xffffu); vt[7 * 196] = (bf16)(vw.w >> 16);
    }
    __syncthreads();
    {
        const int hq = 4 * kvh + (F.wave >> 1);
        bf16* qrow = F.big + (size_t)(64 * cid + 32 * (F.wave & 1) + (F.lane & 31)) * PITCH + C_Q1 + 64 * hq;
        const int lo = sample ? 0 : (128 - 64 * cid);
        attn_core<64, 6, 72, 196>(Ks, Vs, qrow, 0.125f, F.inp(24)[hq], true, lo, F.lane);
    }
    __syncthreads();
}

struct SchedT {
    pg8::TileOrder T; const char* A; const char* B; size_t astep, bstep;
    __device__ bool next(int i, pg8::Unit& u) const {
        const long L = (long)i * T.G + T.c;
        if (!T.tile(L, u.pm, u.pn)) return false;
        u.kind = 0; u.A = A + (size_t)u.pm * astep; u.B = B + (size_t)u.pn * bstep; return true;
    }
};
template <bool FROM_INPUT, bool WRITE_XB>
struct EpiRes {
    static constexpr bool PERM = false;
    const float* xp; const float* xs; float* out; bf16* big; float* rss;
    __device__ __forceinline__ void operator()(const f32x4 (&acc)[2][2][4][2], const pg8::Unit& u, int wr, int wc, int fr, int fq) const {
        asm volatile("" : "+v"(fr), "+v"(fq));
        const int row0 = u.pm * 256 + wr * 64 + fr, col0 = u.pn * 256 + wc * 32 + 4 * fq;
#pragma unroll
        for (int ai = 0; ai < 2; ++ai)
#pragma unroll
            for (int m = 0; m < 4; ++m) {
                const int row = row0 + ai * 128 + m * 16;
                const float* base = FROM_INPUT ? (row < SEQ ? xp + (size_t)row * D : xs + (size_t)(row - SEQ) * D) : out + (size_t)row * D;
                float* o = out + (size_t)row * D; float ss = 0.f;
#pragma unroll
                for (int bj = 0; bj < 2; ++bj)
#pragma unroll
                    for (int n = 0; n < 2; ++n) {
                        const int c = col0 + bj * 128 + n * 16;
                        const f32x4 x = *(const f32x4*)(base + c) + acc[ai][bj][m][n];
                        *(f32x4*)(o + c) = x;
                        if (WRITE_XB) { *(u32x2*)(big + (size_t)row * PITCH + C_XB + c) = (u32x2){pk2(x.x, x.y), pk2(x.z, x.w)}; ss += (x.x * x.x + x.y * x.y) + (x.z * x.z + x.w * x.w); }
                    }
                if (WRITE_XB) { ss += __shfl_xor(ss, 16); ss += __shfl_xor(ss, 32); if (fq == 0) atomicAdd(rss + row, ss); }
                asm volatile("" ::: "memory");
            }
    }
};
struct EpiSwiglu {
    static constexpr bool PERM = true;
    bf16* big; const float* rss;
    __device__ __forceinline__ void operator()(const f32x4 (&acc)[2][2][4][2], const pg8::Unit& u, int wr, int wc, int fr, int fq) const {
        asm volatile("" : "+v"(fr), "+v"(fq));
        const int row0 = u.pm * 256 + wr * 64 + fr, col = C_ACT + u.pn * 128 + wc * 32 + 8 * fq;
#pragma unroll
        for (int ai = 0; ai < 2; ++ai)
#pragma unroll
            for (int m = 0; m < 4; ++m) {
                const int row = row0 + ai * 128 + m * 16;
                const float inv = 1.0f / sqrtf(rss[row] * (1.0f / 1024.0f) + EPS);
                float a[8];
#pragma unroll
                for (int n = 0; n < 2; ++n)
#pragma unroll
                    for (int j = 0; j < 4; ++j) { const float g = acc[ai][0][m][n][j] * inv, up = acc[ai][1][m][n][j] * inv; a[4 * n + j] = silu_f(g) * up; }
                *(u32x4*)(big + (size_t)row * PITCH + col) = (u32x4){pk2(a[0], a[1]), pk2(a[2], a[3]), pk2(a[4], a[5]), pk2(a[6], a[7])};
            }
    }
};
struct EpiScale {
    static constexpr bool PERM = true;
    bf16* big; const float* rss; int colbase;
    __device__ __forceinline__ void operator()(const f32x4 (&acc)[2][2][4][2], const pg8::Unit& u, int wr, int wc, int fr, int fq) const {
        asm volatile("" : "+v"(fr), "+v"(fq));
        const int row0 = u.pm * 256 + wr * 64 + fr, col = colbase + u.pn * 256 + wc * 32 + 8 * fq;
#pragma unroll
        for (int ai = 0; ai < 2; ++ai)
#pragma unroll
            for (int m = 0; m < 4; ++m) {
                const int row = row0 + ai * 128 + m * 16;
                const float inv = 1.0f / sqrtf(rss[row] * (1.0f / 1024.0f) + EPS);
#pragma unroll
                for (int bj = 0; bj < 2; ++bj) {
                    const f32x4 v0 = acc[ai][bj][m][0] * inv, v1 = acc[ai][bj][m][1] * inv;
                    *(u32x4*)(big + (size_t)row * PITCH + col + bj * 128) = (u32x4){pk2(v0[0], v0[1]), pk2(v0[2], v0[3]), pk2(v1[0], v1[1]), pk2(v1[2], v1[3])};
                }
            }
    }
};
template <class Epi>
__device__ __forceinline__ void run_gemm(Frame& F, int nN, int K, int acol, size_t wofs, const Epi& E) {
    SchedT S; S.T.init(66, nN, F.G, F.bid); S.A = (const char*)(F.big + acol); S.B = (const char*)(F.ws + wofs); S.astep = (size_t)256 * PITCH * 2; S.bstep = (size_t)256 * K * 2;
    pg8::gemm_phase<Epi, SchedT>(F.lds, F.tid, K, PITCH, S, E);
}

__global__ void __launch_bounds__(512, 2) mega_fwd(Args args) {
    extern __shared__ __attribute__((aligned(16))) unsigned char lds_raw[];
    Frame F;
    F.lds = (LAS unsigned char*)lds_raw;
    F.tid = threadIdx.x; F.lane = F.tid & 63; F.wave = __builtin_amdgcn_readfirstlane(F.tid >> 6);
    F.G = gridDim.x; F.bid = blockIdx.x;
    F.ka = (const float* const*)__builtin_amdgcn_kernarg_segment_ptr(); F.out = args.out; F.ws = args.ws;
    F.ctl = (gu32*)(args.ws + WS_CTL);
    F.big = (bf16*)(args.ws + WS_BIG);
    volatile LAS unsigned* MISC = (volatile LAS unsigned*)(F.lds + MISC_OFF);
    if (F.tid < 64) MISC[F.tid] = 0u;
    __syncthreads();
    XcdBarrier bar = xcd_barrier_post((unsigned*)(F.ctl + CW_BAR), MISC + 8);
    unsigned long long t_probe0 = (PROBE_A == 0) ? __builtin_amdgcn_s_memrealtime() : 0ull, t_probe1 = 0; int phase_no = 0;
#define GRID_BAR() do { xcd_barrier(bar); PHASE_FENCE(); ++phase_no; if (PROBE_A >= 0) { if (phase_no == PROBE_A) t_probe0 = __builtin_amdgcn_s_memrealtime(); if (phase_no == PROBE_A + 1) t_probe1 = __builtin_amdgcn_s_memrealtime(); } } while (0)

    p0_prologue(F);
    GRID_BAR();
    if (LAST_PHASE < 1) return;
    {
        SchedP1 S; S.T.init(66, 19, F.G, F.bid); S.A = (const char*)F.out; S.B = (const char*)(F.ws + WS_WA); S.Amem = (const char*)(F.ws + WS_MEMB); S.Bmem = (const char*)(F.ws + WS_WMEM);
        EpiP1 E{F.big, (bf16*)(F.ws + WS_HALO), (float*)(F.ws + WS_BA), (const float*)(F.ws + WS_ROWSS0), (float*)(F.ws + WS_KVRAW), F.out};
        pg8::gemm_phase<EpiP1, SchedP1>(F.lds, F.tid, 1024, 1024, S, E);
    }
    GRID_BAR();
    if (LAST_PHASE < 2) return;
    fix_items(F, F.bid * 8 + F.wave, F.G * 8);
    { int last_hp = -1; for (int u = F.bid; u < NCH * 4; u += F.G) { if ((u & 3) != last_hp) { last_hp = u & 3; __syncthreads(); prep_load_cw(F, last_hp); __syncthreads(); } prep_unit(F, u >> 2, u & 3); } }
    GRID_BAR();
    if (LAST_PHASE < 3) return;
    for (int t = F.bid; t < 256; t += F.G) gdn_l1(F, t >> 3, t & 7);
    GRID_BAR();
    if (F.bid < 8) gdn_l2(F, F.bid, F.out + O_STATE_P + (size_t)F.bid * 16384);
    else if (F.bid < 72) { const int t = F.bid - 8, b = t >> 3, h = t & 7; gdn_scan(F, 256 + b, 1, h, F.inp(5) + (size_t)(b * 8 + h) * 16384, false, F.out + O_STATE_S + (size_t)(b * 8 + h) * 16384); }
    else for (int u = F.bid - 72; u < 288; u += F.G - 72) mem_attn_unit(F, 0, u, C_QM0);
    GRID_BAR();
    for (int t = F.bid; t < 256; t += F.G) { const int g = t >> 3, h = t & 7; gdn_scan(F, 8 * g, 8, h, g ? (const float*)(F.ws + WS_HSLOT) + ((size_t)(g - 1) * 8 + h) * 16384 : nullptr, true, nullptr); }
    GRID_BAR();
    if (LAST_PHASE < 4) return;
    float* rss1 = (float*)(F.ctl + CW_RSS1); float* rss2 = (float*)(F.ctl + CW_RSS2); float* rss3 = (float*)(F.ctl + CW_RSS3);
    { EpiRes<true, true> E{F.inp(0), F.inp(1), F.out, F.big, rss1}; run_gemm(F, 4, 1536, C_Z, WS_WOA, E); }
    GRID_BAR();
    { EpiSwiglu E{F.big, rss1}; run_gemm(F, 22, 1024, C_XB, WS_WGU0, E); }
    GRID_BAR();
    { EpiRes<false, true> E{nullptr, nullptr, F.out, F.big, rss2}; run_gemm(F, 4, 2816, C_ACT, WS_WD0, E); }
    GRID_BAR();
    if (LAST_PHASE < 8) return;
    { EpiScale E{F.big, rss2, C_Q1}; run_gemm(F, 8, 1024, C_XB, WS_WB, E); }
    GRID_BAR();
    for (int u = F.bid; u < 1056 + 288; u += F.G) { if (u < 1056) swa_unit(F, u >> 2, u & 3); else mem_attn_unit(F, 1, u - 1056, C_QM1); }
    GRID_BAR();
    { EpiRes<false, true> E{nullptr, nullptr, F.out, F.big, rss3}; run_gemm(F, 4, 1536, C_Q1, WS_WOB, E); }
    GRID_BAR();
    { EpiSwiglu E{F.big, rss3}; run_gemm(F, 22, 1024, C_XB, WS_WGU1, E); }
    GRID_BAR();
    { EpiRes<false, false> E{nullptr, nullptr, F.out, F.big, nullptr}; run_gemm(F, 4, 2816, C_ACT, WS_WD1, E); }
    if (PROBE_A >= 0) { GRID_BAR(); if (F.bid == 0 && F.tid == 0) F.out[0] += (float)(t_probe1 - t_probe0) * 1e-4f; }
#ifdef DBG_ZERO
    {
        const size_t gt = (size_t)F.bid * 512 + F.tid, GT = (size_t)F.G * 512;
        for (size_t i = gt; i < O_STATE_P; i += GT) F.out[i] = 0.f;
        for (size_t i = O_KP + gt; i < O_MEMK; i += GT) F.out[i] = 0.f;
        for (size_t i = O_STATE_P + gt; i < O_CONV_P; i += GT) F.out[i] *= 3.f;
    }
#endif
}

extern "C" void kernel_launch(void* const* d_in, const int* in_sizes, int n_in, void* d_out, int out_size, void* d_ws, size_t ws_size, hipStream_t stream) {
    static int grid = 0;
    if (grid == 0) {
        int dev = 0, cus = 0, per_cu = 0;
        if (n_in != 28 || ws_size < WS_END) { fprintf(stderr, "kernel_launch: unexpected n_in %d / ws %zu\n", n_in, ws_size); grid = -1; return; }
        if (hipGetDevice(&dev) != hipSuccess || hipDeviceGetAttribute(&cus, hipDeviceAttributeMultiprocessorCount, dev) != hipSuccess) { grid = -1; return; }
        if (hipFuncSetAttribute((const void*)mega_fwd, hipFuncAttributeMaxDynamicSharedMemorySize, LDS_BYTES) != hipSuccess) { fprintf(stderr, "kernel_launch: hipFuncSetAttribute failed\n"); grid = -1; return; }
        if (hipOccupancyMaxActiveBlocksPerMultiprocessor(&per_cu, (const void*)mega_fwd, 512, LDS_BYTES) != hipSuccess || per_cu < 1) { fprintf(stderr, "kernel_launch: occupancy query says %d\n", per_cu); per_cu = 1; }
        (void)hipGetLastError();
        grid = cus;
    }
    if (grid < 0) return;
    (void)hipMemsetAsync((char*)d_ws + WS_CTL, 0, CTL_ZERO_BYTES, stream);
    Args a{};
    for (int i = 0; i < 28; ++i) a.in[i] = (const float*)d_in[i];
    a.out = (float*)d_out; a.ws = (unsigned char*)d_ws;
    hipLaunchKernelGGL(mega_fwd, dim3(grid), dim3(512), LDS_BYTES, stream, a);
}
```

```cpp
#include <hip/hip_runtime.h>
#include <cstdio>
#include <cstdint>

#define LAS __attribute__((address_space(3)))
#define GAS __attribute__((address_space(1)))
typedef unsigned short bf16;
typedef short bf16x8 __attribute__((ext_vector_type(8)));
typedef short s16x4 __attribute__((ext_vector_type(4)));
typedef float f32x4 __attribute__((ext_vector_type(4)));
typedef float f32x2 __attribute__((ext_vector_type(2)));
typedef float f32x16 __attribute__((ext_vector_type(16)));
typedef unsigned u32x4 __attribute__((ext_vector_type(4)));
typedef unsigned u32x2 __attribute__((ext_vector_type(2)));
typedef GAS unsigned gu32;

#ifndef PROBE_A
#define PROBE_A -1
#endif
#ifndef LAST_PHASE
#define LAST_PHASE 99
#endif

constexpr int D = 1024, SEQ = 16384, NTOK = 16896, NCH = 264  ;
constexpr int PITCH = 4608;
constexpr int DFF = 2816;
constexpr float EPS = 1e-6f;
constexpr int C_Z = 3072, C_QM0 = 4096;
constexpr int C_XB = 0, C_ACT = 1024, C_Q1 = 1024, C_QM1 = 2048, C_K1 = 2560, C_V1 = 2816;

constexpr size_t O_Y = 0, O_STATE_P = 17301504, O_CONV_P = 17432576, O_STATE_S = 17441792, O_CONV_S = 18490368, O_KP = 18564096, O_VP = 18596864,
                 O_KS = 18629632, O_VS = 18760704, O_MEMK = 18891776, O_MEMV = 19153920;

constexpr size_t MiB = 1u << 20;
constexpr size_t WS_CTL = 0, CTL_ZERO_BYTES = 1 * MiB;
constexpr size_t WS_ROWSS0 = 1 * MiB;
constexpr size_t WS_BA = 2 * MiB;
constexpr size_t WS_HALO = 4 * MiB;
constexpr size_t WS_KVRAW = 9 * MiB;
constexpr size_t WS_MEMB = 11 * MiB;
constexpr size_t WS_ACHUNK = 11 * MiB + 768 * 1024;
constexpr size_t WS_SWAC = 12 * MiB;
constexpr size_t WS_KVIMG = 13 * MiB;
constexpr size_t WS_MG = 22 * MiB;
constexpr size_t WS_HSLOT = 30 * MiB;
constexpr size_t WS_WA = 46 * MiB;
constexpr size_t WS_WOA = WS_WA + (size_t)4864 * 1024 * 2;
constexpr size_t WS_WGU0 = WS_WOA + (size_t)1024 * 1536 * 2;
constexpr size_t WS_WD0 = WS_WGU0 + (size_t)5632 * 1024 * 2;
constexpr size_t WS_WB = WS_WD0 + (size_t)1024 * 2816 * 2;
constexpr size_t WS_WOB = WS_WB + (size_t)2048 * 1024 * 2;
constexpr size_t WS_WGU1 = WS_WOB + (size_t)1024 * 1536 * 2;
constexpr size_t WS_WD1 = WS_WGU1 + (size_t)5632 * 1024 * 2;
constexpr size_t WS_WMEM = WS_WD1 + (size_t)1024 * 2816 * 2;
constexpr size_t WS_WEND = WS_WMEM + (size_t)2 * 1024 * 1024 * 2;
constexpr size_t WS_BIG = 103 * MiB;
constexpr size_t WS_END = WS_BIG + (size_t)NTOK * PITCH * 2;
static_assert(WS_WEND <= WS_BIG && WS_END <= 256 * MiB, "d_ws map");
constexpr int CW_BAR = 4096;
constexpr int CW_RSS1 = 65536, CW_RSS2 = CW_RSS1 + 16896, CW_RSS3 = CW_RSS2 + 16896;
static_assert((CW_RSS3 + 16896) * 4 <= (int)CTL_ZERO_BYTES, "ctl");
constexpr size_t QX_BYTES = 24576;

constexpr int RING_BYTES = 131072;
constexpr int MISC_OFF = 163328;
constexpr int LDS_BYTES = 163840;

#define RLX_AGENT __ATOMIC_RELAXED, __HIP_MEMORY_SCOPE_AGENT
#define LDS_WAIT() asm volatile("s_waitcnt lgkmcnt(0)" ::: "memory")
#define VM_WAIT() asm volatile("s_waitcnt vmcnt(0)" ::: "memory")
typedef __bf16 bf16x2_t __attribute__((ext_vector_type(2)));
__device__ __forceinline__ unsigned pk2(float lo, float hi) { f32x2 v = {lo, hi}; bf16x2_t b = __builtin_convertvector(v, bf16x2_t); return __builtin_bit_cast(unsigned, b); }
__device__ __forceinline__ float bf2f(unsigned short b) { return __uint_as_float((unsigned)b << 16); }
__device__ __forceinline__ float bflo(unsigned w) { return __uint_as_float(w << 16); }
__device__ __forceinline__ float bfhi(unsigned w) { return __uint_as_float(w & 0xffff0000u); }
__device__ __forceinline__ float wave_sum(float v) {
#pragma unroll
    for (int o = 1; o < 64; o <<= 1) v += __shfl_xor(v, o);
    return v;
}
__device__ __forceinline__ float fast_exp(float x) { return __builtin_amdgcn_exp2f(x * 1.4426950408889634f); }
__device__ __forceinline__ float silu_f(float x) { return x * __builtin_amdgcn_rcpf(1.0f + __expf(-x)); }

#define XB_TMO      128
#define XB_XCNT(j)  (256  + 64 * (j))
#define XB_XSUB(j)  (1280 + 64 * (j))
#define XB_XGEN(j)  (2304 + 64 * (j))
#define XB_TOP      3328
#define XB_TOPGEN   3392
#define XCD_BAR_WORDS 3456
#define XB_SPIN_CAP (1u << 22)
__device__ __forceinline__ unsigned xb_ld(unsigned* p)              { return __hip_atomic_load(p, __ATOMIC_RELAXED, __HIP_MEMORY_SCOPE_AGENT); }
__device__ __forceinline__ unsigned xb_add(unsigned* p, unsigned v) { return __hip_atomic_fetch_add(p, v, __ATOMIC_RELAXED, __HIP_MEMORY_SCOPE_AGENT); }
__device__ __forceinline__ unsigned xb_xcc_id() { return (unsigned)__builtin_amdgcn_s_getreg((3 << 11) | 20) & 0xFu; }
#define XB_SPIN(cond, bar) do { unsigned _sp = 0; while (cond) { __builtin_amdgcn_s_sleep(1); \
    if ((++_sp & 255u) == 0u) { if (xb_ld(&(bar)[XB_TMO])) break; if (_sp > XB_SPIN_CAP) { atomicAdd(&(bar)[XB_TMO], 1u); break; } } } } while (0)
struct XcdBarrier { unsigned* bar; unsigned x; volatile LAS unsigned* st; };
__device__ __forceinline__ XcdBarrier xcd_barrier_post(unsigned* bar, volatile LAS unsigned* st) {
    XcdBarrier b; b.bar = bar; b.x = xb_xcc_id(); b.st = st;
    if (threadIdx.x == 0) (void)xb_add(&bar[XB_XCNT(b.x)], 1u);
    return b;
}
__device__ __forceinline__ void xcd_barrier_complete(unsigned* bar, unsigned x, unsigned& nloc, unsigned& nx) {
    const unsigned G = gridDim.x * gridDim.y * gridDim.z;
    unsigned sum, cnt, mine, sp = 0u;
    for (;;) {
        sum = 0u; cnt = 0u; mine = 0u;
#pragma unroll
        for (unsigned j = 0; j < 16; ++j) { const unsigned c = xb_ld(&bar[XB_XCNT(j)]); sum += c; cnt += (c > 0u) ? 1u : 0u; mine = (j == x) ? c : mine; }
        if (sum == G) break;
        __builtin_amdgcn_s_sleep(1);
        if ((++sp & 255u) == 0u) { if (xb_ld(&bar[XB_TMO])) break; if (sp > XB_SPIN_CAP) { atomicAdd(&bar[XB_TMO], 1u); break; } }
    }
    nloc = mine > 0u ? mine : 1u; nx = cnt > 0u ? cnt : 1u;
}
__device__ __forceinline__ void xcd_barrier(const XcdBarrier& b) {
    asm volatile("s_waitcnt vmcnt(0)" ::: "memory");
    __syncthreads();
    if (threadIdx.x == 0) {
        unsigned* bar = b.bar;
        __builtin_amdgcn_s_waitcnt(0);
        unsigned nloc = b.st[0], nx = b.st[1];
        if (nloc == 0u) { xcd_barrier_complete(bar, b.x, nloc, nx); b.st[0] = nloc; b.st[1] = nx; }
        const unsigned old = xb_add(&bar[XB_XSUB(b.x)], 1u);
        const unsigned gen = old / nloc;
        if (old + 1u == (gen + 1u) * nloc) {
            __builtin_amdgcn_fence(__ATOMIC_RELEASE, "agent");
            asm volatile("s_waitcnt vmcnt(0)" ::: "memory");
            const unsigned og = xb_add(&bar[XB_TOP], 1u);
            const unsigned tg = og / nx;
            if (og + 1u == (tg + 1u) * nx) xb_add(&bar[XB_TOPGEN], 1u);
            else XB_SPIN(xb_ld(&bar[XB_TOPGEN]) == tg, bar);
            __builtin_amdgcn_fence(__ATOMIC_ACQUIRE, "agent");
            xb_add(&bar[XB_XGEN(b.x)], 1u);
            asm volatile("s_waitcnt vmcnt(0)" ::: "memory");
        } else {
            XB_SPIN(xb_ld(&bar[XB_XGEN(b.x)]) == gen, bar);
            __builtin_amdgcn_fence(__ATOMIC_ACQUIRE, "agent");
            asm volatile("s_waitcnt vmcnt(0)" ::: "memory");
        }
    }
    __syncthreads();
}

struct Args { const float* in[28]; float* out; unsigned char* ws; };
struct Frame {
    LAS unsigned char* lds;
    gu32* ctl;
    int tid, lane, wave, G, bid;
    const float* const* ka;
    float* out; unsigned char* ws;
    bf16* big;
    __device__ __forceinline__ const float* inp(int k) const { return ka[k]; }
};
#define PHASE_FENCE() do { int t_ = F.tid; asm volatile("" : "+v"(t_)); F.tid = t_; F.lane = t_ & 63; const float* const* k_ = F.ka; asm volatile("" : "+s"(k_)); F.ka = k_; } while (0)

namespace pg8 {
constexpr int BM = 256, BK = 64, HALF = 128, HTB = HALF * BK * 2, STAGE_BYTES = 8 * HTB, NXCD = 8, WGM = 8;
__host__ __device__ __forceinline__ int lds_byte(int r, int c) { const int st = (r >> 4) * 2 + (c >> 5), rr = r & 15, cc = c & 31, ob = rr * 64 + cc * 2; return st * 1024 + (ob ^ (((ob >> 9) & 1) << 5)); }
__host__ __device__ __forceinline__ void stage_rc(int b, int& R, int& C) { const int st = b / 1024, sb = b % 1024, swz = sb ^ (((sb >> 9) & 1) << 5); R = (st >> 1) * 16 + swz / 64; C = (st & 1) * 32 + (swz % 64) / 2; }
__host__ __device__ __forceinline__ int perm32(int rho) { const int n = rho >> 4, i = rho & 15; return 8 * (i >> 2) + 4 * n + (i & 3); }

struct Unit { int pm, pn, kind; const char* A; const char* B; };
struct TileOrder {
    int nM, nN, nwg, G, c;
    __device__ void init(int nM_, int nN_, int G_, int c_) { nM = nM_; nN = nN_; nwg = nM * nN; G = G_; c = c_; }
    __device__ bool tile(long L, int& pm, int& pn) const {
        if (L >= nwg) return false;
        int wgid = (int)L; { const int q = nwg / NXCD, r = nwg % NXCD, xcd = wgid % NXCD, off = wgid / NXCD; wgid = (xcd < r ? xcd * (q + 1) : r * (q + 1) + (xcd - r) * q) + off; }
        const int nig = WGM * nN, gid = wgid / nig, fm = gid * WGM, gsz = (nM - fm) < WGM ? (nM - fm) : WGM;
        pm = fm + ((wgid % nig) % gsz); pn = (wgid % nig) / gsz; return true;
    }
};

template <class Epi, class Sched>
__device__ __forceinline__ void gemm_phase(LAS unsigned char* lds, const int tid, const int K, const int lda, const Sched& S, const Epi& E) {
    const int wid = __builtin_amdgcn_readfirstlane(tid >> 6), lane = tid & 63, wr = wid >> 2, wc = wid & 3, fr = lane & 15, fq = lane >> 4;
    const int nt = K / BK;
    unsigned voffA[2], voffB[2];
#pragma unroll
    for (int i = 0; i < 2; ++i) { int R, C; stage_rc(tid * 16 + i * 8192, R, C); const int Rb = Epi::PERM ? ((R & ~31) + perm32(R & 31)) : R;
        voffA[i] = (unsigned)(R * lda + C) * 2u; voffB[i] = (unsigned)(Rb * K + C) * 2u; }
    const size_t kstep = (size_t)(BK * 2);
    const size_t hstepA = (size_t)HALF * lda * 2, hstepB = (size_t)HALF * K * 2;
    const unsigned ldsw = (unsigned)wid * 1024u;
    const int aoff = lds_byte(wr * 64 + fr, fq * 8), boff = lds_byte(wc * 32 + fr, fq * 8);
#define PG8_SA(b, h) (((b) * 2 + (h)) * HTB)
#define PG8_SB(b, h) ((4 + (b) * 2 + (h)) * HTB)
#define PG8_STAGE(bufoff, gbase, voff) do { _Pragma("unroll") for (int _i = 0; _i < 2; ++_i) \
        __builtin_amdgcn_global_load_lds((const unsigned*)((const char*)(gbase) + (voff)[_i]), (LAS unsigned*)(lds + (bufoff) + ldsw + _i * 8192), 16, 0, 0); } while (0)
#define PG8_LDA(dst, b, h) do { _Pragma("unroll") for (int m = 0; m < 4; ++m) _Pragma("unroll") for (int k = 0; k < 2; ++k) dst[m][k] = *(const LAS bf16x8*)(lds + PG8_SA(b, h) + aoff + m * 2048 + k * 1024); } while (0)
#define PG8_LDB(dst, b, h) do { _Pragma("unroll") for (int n = 0; n < 2; ++n) _Pragma("unroll") for (int k = 0; k < 2; ++k) dst[n][k] = *(const LAS bf16x8*)(lds + PG8_SB(b, h) + boff + n * 2048 + k * 1024); } while (0)
#define PG8_MMA(ai, bj, At, Bt) do { __builtin_amdgcn_s_setprio(1); _Pragma("unroll") for (int m = 0; m < 4; ++m) _Pragma("unroll") for (int n = 0; n < 2; ++n) _Pragma("unroll") for (int k = 0; k < 2; ++k) \
        acc[ai][bj][m][n] = __builtin_amdgcn_mfma_f32_16x16x32_bf16(Bt[n][k], At[m][k], acc[ai][bj][m][n], 0, 0, 0); __builtin_amdgcn_s_setprio(0); } while (0)
#define PG8_WAIT_V(n) asm volatile("s_waitcnt vmcnt(" #n ")" ::: "memory")
#define PG8_WAIT_L(n) asm volatile("s_waitcnt lgkmcnt(" #n ")" ::: "memory")
#define PG8_BAR __builtin_amdgcn_s_barrier()
#define PG8_SCHED __builtin_amdgcn_sched_barrier(0)
    Unit cur, nxt; int ui = 0;
    if (!S.next(0, cur)) return;
    f32x4 acc[2][2][4][2];
#pragma unroll
    for (int a = 0; a < 2; ++a)
#pragma unroll
        for (int b = 0; b < 2; ++b)
#pragma unroll
            for (int m = 0; m < 4; ++m)
#pragma unroll
                for (int n = 0; n < 2; ++n) acc[a][b][m][n] = (f32x4){0.f, 0.f, 0.f, 0.f};
    bf16x8 At[4][2], B0[2][2], B1[2][2];
    const char* cA = cur.A; const char* cB = cur.B;
    PG8_STAGE(PG8_SB(0, 0), cB, voffB); PG8_STAGE(PG8_SB(0, 1), cB + hstepB, voffB); PG8_STAGE(PG8_SA(0, 0), cA, voffA); PG8_STAGE(PG8_SA(0, 1), cA + hstepA, voffA);
    if (wr == 1) PG8_BAR;
    PG8_WAIT_V(2); PG8_BAR;
    PG8_STAGE(PG8_SB(1, 0), cB + kstep, voffB); PG8_STAGE(PG8_SA(1, 0), cA + kstep, voffA); PG8_STAGE(PG8_SB(1, 1), cB + hstepB + kstep, voffB);
    PG8_WAIT_V(6); PG8_BAR;
    for (;;) {
        const bool has_next = S.next(ui + 1, nxt);
        const char* nA = has_next ? nxt.A : cA; const char* nB = has_next ? nxt.B : cB;
        for (int t = 0; t < nt; t += 2) {
            const bool last = (t == nt - 2);
            const char* a1 = cA + (size_t)(t + 1) * kstep;
            const char* a2 = last ? nA : cA + (size_t)(t + 2) * kstep; const char* b2 = last ? nB : cB + (size_t)(t + 2) * kstep;
            const char* a3 = a2 + kstep; const char* b3 = b2 + kstep;
            PG8_LDB(B0, 0, 0); PG8_LDB(B1, 0, 1); PG8_SCHED; PG8_LDA(At, 0, 0); PG8_STAGE(PG8_SA(1, 1), a1 + hstepA, voffA);
            PG8_WAIT_V(8); PG8_WAIT_L(0); PG8_BAR; PG8_MMA(0, 0, At, B0); PG8_MMA(0, 1, At, B1); PG8_BAR; PG8_SCHED;
            PG8_LDA(At, 0, 1); PG8_STAGE(PG8_SB(0, 0), b2, voffB); PG8_STAGE(PG8_SB(0, 1), b2 + hstepB, voffB); PG8_STAGE(PG8_SA(0, 0), a2, voffA);
            PG8_WAIT_V(8); PG8_WAIT_L(0); PG8_BAR; PG8_MMA(1, 0, At, B0); PG8_MMA(1, 1, At, B1); PG8_BAR; PG8_SCHED;
            PG8_LDB(B0, 1, 0); PG8_LDB(B1, 1, 1); PG8_SCHED; PG8_LDA(At, 1, 0); PG8_STAGE(PG8_SA(0, 1), a2 + hstepA, voffA);
            PG8_WAIT_V(8); PG8_WAIT_L(0); PG8_BAR; PG8_MMA(0, 0, At, B0); PG8_MMA(0, 1, At, B1); PG8_BAR; PG8_SCHED;
            PG8_LDA(At, 1, 1); PG8_STAGE(PG8_SB(1, 0), b3, voffB); PG8_STAGE(PG8_SB(1, 1), b3 + hstepB, voffB); PG8_STAGE(PG8_SA(1, 0), a3, voffA);
            PG8_WAIT_V(8); PG8_WAIT_L(0); PG8_BAR; PG8_MMA(1, 0, At, B0); PG8_MMA(1, 1, At, B1); PG8_BAR; PG8_SCHED;
        }
        if (wr == 0) PG8_BAR;
        E(acc, cur, wr, wc, fr, fq);
        if (!has_next) break;
#pragma unroll
        for (int a = 0; a < 2; ++a)
#pragma unroll
            for (int b = 0; b < 2; ++b)
#pragma unroll
                for (int m = 0; m < 4; ++m)
#pragma unroll
                    for (int n = 0; n < 2; ++n) acc[a][b][m][n] = (f32x4){0.f, 0.f, 0.f, 0.f};
        cur = nxt; cA = nA; cB = nB; ++ui;
        if (wr == 1) PG8_BAR;
    }
    PG8_WAIT_V(0);
    PG8_BAR;
#undef PG8_SA
#undef PG8_SB
#undef PG8_STAGE
#undef PG8_LDA
#undef PG8_LDB
#undef PG8_MMA
#undef PG8_WAIT_V
#undef PG8_WAIT_L
#undef PG8_BAR
#undef PG8_SCHED
}
}

__device__ __forceinline__ void tr_item(const float* W, int ldw, bf16* WT, int K, int k0, int dst_row0, int src_col0, int nvalid, const float* gain, LAS float* scr, int lane) {
    const int n = lane & 31;
#pragma unroll 8
    for (int i = 0; i < 32; ++i) { const int kk = 2 * i + (lane >> 5);
        float v = (n < nvalid) ? W[(size_t)(k0 + kk) * ldw + src_col0 + n] : 0.f;
        if (gain) v *= gain[k0 + kk];
        scr[kk * 33 + n] = v; }
    LDS_WAIT(); asm volatile("" ::: "memory");
    const int c = lane & 7;
#pragma unroll
    for (int j = 0; j < 4; ++j) { const int nn = (lane >> 3) + 8 * j; const LAS float* s = scr + (8 * c) * 33 + nn;
        u32x4 o; o.x = pk2(s[0 * 33], s[1 * 33]); o.y = pk2(s[2 * 33], s[3 * 33]); o.z = pk2(s[4 * 33], s[5 * 33]); o.w = pk2(s[6 * 33], s[7 * 33]);
        *(GAS u32x4*)(WT + (size_t)(dst_row0 + nn) * K + k0 + 8 * c) = o; }
    LDS_WAIT(); asm volatile("" ::: "memory");
}
__device__ __forceinline__ void wt_item(Frame& F, int it, LAS float* scr) {
    const float* W; int ldw, K, nblk, map; bf16* dst; const float* gain;
    int r = it;
    if (r < 2432) { W = F.inp(15); ldw = 4624; K = 1024; nblk = 152; map = 1; dst = (bf16*)(F.ws + WS_WA); gain = F.inp(9); }
    else if ((r -= 2432) < 768) { W = F.inp(20); ldw = 1024; K = 1536; nblk = 32; map = 0; dst = (bf16*)(F.ws + WS_WOA); gain = nullptr; }
    else if ((r -= 768) < 2816) { W = F.inp(26); ldw = 5632; K = 1024; nblk = 176; map = 2; dst = (bf16*)(F.ws + WS_WGU0); gain = F.inp(10); }
    else if ((r -= 2816) < 1408) { W = F.inp(27); ldw = 1024; K = 2816; nblk = 32; map = 0; dst = (bf16*)(F.ws + WS_WD0); gain = nullptr; }
    else if ((r -= 1408) < 1024) { W = F.inp(21); ldw = 2048; K = 1024; nblk = 64; map = 3; dst = (bf16*)(F.ws + WS_WB); gain = F.inp(9) + 1024; }
    else if ((r -= 1024) < 768) { W = F.inp(25); ldw = 1024; K = 1536; nblk = 32; map = 0; dst = (bf16*)(F.ws + WS_WOB); gain = nullptr; }
    else if ((r -= 768) < 2816) { W = F.inp(26) + (size_t)1024 * 5632; ldw = 5632; K = 1024; nblk = 176; map = 2; dst = (bf16*)(F.ws + WS_WGU1); gain = F.inp(10) + 1024; }
    else if ((r -= 2816) < 1408) { W = F.inp(27) + (size_t)2816 * 1024; ldw = 1024; K = 2816; nblk = 32; map = 0; dst = (bf16*)(F.ws + WS_WD1); gain = nullptr; }
    else if ((r -= 1408) < 512) { W = F.inp(12); ldw = 1024; K = 1024; nblk = 32; map = 0; dst = (bf16*)(F.ws + WS_WMEM); gain = F.inp(11); }
    else { r -= 512; W = F.inp(12) + (size_t)1024 * 1024; ldw = 1024; K = 1024; nblk = 32; map = 0; dst = (bf16*)(F.ws + WS_WMEM) + (size_t)1024 * 1024; gain = F.inp(11) + 1024; }
    const int kb = r / nblk, nb = r % nblk;
    int src0 = 32 * nb, nv = 32;
    if (map == 1) { if (nb < 128) { src0 = 32 * nb; } else if (nb < 144) { src0 = 4112 + 32 * (nb - 128); } else if (nb == 144) { src0 = 4096; nv = 16; } else { src0 = 0; nv = 0; } }
    else if (map == 2) { const int pn = nb >> 3, w = nb & 7; src0 = (w < 4) ? (128 * pn + 32 * w) : (2816 + 128 * pn + 32 * (w - 4)); }
    else if (map == 3) { if (nb < 32) src0 = 32 * nb; else if (nb < 48) src0 = 1536 + 32 * (nb - 32); else src0 = 1024 + 32 * (nb - 48); }
    tr_item(W, ldw, dst, K, 64 * kb, 32 * nb, src0, nv, gain, scr, F.lane);
}
constexpr int N_WT_ITEMS = 14464;
__device__ __forceinline__ void row_to_bf16(const float* xrow, bf16* orow, float* ss, int lane) {
    const GAS f32x4* xr = (const GAS f32x4*)xrow + lane;
    f32x4 v[4]; float s = 0.f;
#pragma unroll
    for (int j = 0; j < 4; ++j) { v[j] = xr[64 * j]; s += (v[j].x * v[j].x + v[j].y * v[j].y) + (v[j].z * v[j].z + v[j].w * v[j].w); }
    s = wave_sum(s);
    GAS u32x2* o8 = (GAS u32x2*)orow + lane;
#pragma unroll
    for (int j = 0; j < 4; ++j) { u32x2 w; w.x = pk2(v[j].x, v[j].y); w.y = pk2(v[j].z, v[j].w); o8[64 * j] = w; }
    if (lane == 0) *ss = s;
}
__device__ __forceinline__ void p0_prologue(Frame& F) {
    LAS float* scr = (LAS float*)(F.lds + F.wave * 16384);
    const int gw = F.bid * 8 + F.wave, NGW = F.G * 8;
    for (int it = gw; it < N_WT_ITEMS - 6016; it += NGW) wt_item(F, it < 7424 ? it : it + 6016, scr);
    bf16* xb = (bf16*)F.out;
    float* rss0 = (float*)(F.ws + WS_ROWSS0);
    for (int m = gw; m < NTOK + 256; m += NGW) {
        if (m < SEQ) row_to_bf16(F.inp(0) + (size_t)m * D, xb + (size_t)m * D, rss0 + m, F.lane);
        else if (m < NTOK) row_to_bf16(F.inp(1) + (size_t)(m - SEQ) * D, xb + (size_t)m * D, rss0 + m, F.lane);
        else row_to_bf16(F.inp(2) + (size_t)(m - NTOK) * D, (bf16*)(F.ws + WS_MEMB) + (size_t)(m - NTOK) * D, rss0 + m, F.lane);
    }
}

struct SchedP1 {
    pg8::TileOrder T; const char* A; const char* B; const char* Amem; const char* Bmem;
    __device__ bool next(int i, pg8::Unit& u) const {
        const long L = (long)i * T.G + T.c;
        if (L < T.nwg) { T.tile(L, u.pm, u.pn); u.kind = 0; u.A = A + (size_t)u.pm * 256 * 1024 * 2; u.B = B + (size_t)u.pn * 256 * 1024 * 2; return true; }
        const int e = (int)(L - T.nwg); if (e >= 8) return false;
        u.pm = 0; u.pn = e; u.kind = 1; u.A = Amem; u.B = Bmem + (size_t)e * 256 * 1024 * 2; return true;
    }
};
struct EpiP1 {
    static constexpr bool PERM = true;
    bf16* big; bf16* halo; float* ba; const float* rss0; float* kvraw; float* out;
    __device__ __forceinline__ void operator()(const f32x4 (&acc)[2][2][4][2], const pg8::Unit& u, int wr, int wc, int fr, int fq) const {
        asm volatile("" : "+v"(fr), "+v"(fq));
        if (u.kind == 0) {
            const int row0 = u.pm * 256 + wr * 64 + fr, colb = u.pn * 256 + wc * 32 + 8 * fq;
#pragma unroll
            for (int ai = 0; ai < 2; ++ai)
#pragma unroll
                for (int m = 0; m < 4; ++m) {
                    const int row = row0 + ai * 128 + m * 16;
                    const float inv = 1.0f / sqrtf(rss0[row] * (1.0f / 1024.0f) + EPS);
#pragma unroll
                    for (int bj = 0; bj < 2; ++bj) {
                        const f32x4 v0 = acc[ai][bj][m][0] * inv, v1 = acc[ai][bj][m][1] * inv; const int col = colb + bj * 128;
                        if (u.pn < 18) {
                            u32x4 w; w.x = pk2(v0[0], v0[1]); w.y = pk2(v0[2], v0[3]); w.z = pk2(v1[0], v1[1]); w.w = pk2(v1[2], v1[3]);
                            *(u32x4*)(big + (size_t)row * PITCH + col) = w;
                            if (m == 3 && fr >= 13 && u.pn < 12) {
                                const int cid = row >> 6, j = fr - 13;
                                *(u32x4*)(halo + ((size_t)cid * 3 + j) * 3072 + col) = w;
                                if (cid >= 255) { float* o = (cid == 255) ? out + O_CONV_P + (size_t)j * 3072 + col : out + O_CONV_S + ((size_t)(cid - 256) * 3 + j) * 3072 + col;
                                    *(f32x4*)o = v0; *(f32x4*)(o + 4) = v1; }
                            }
                        } else if (bj == 0 && wc == 0 && fq < 2) {
                            float* o = ba + (size_t)row * 16 + 8 * fq; *(f32x4*)o = v0; *(f32x4*)(o + 4) = v1;
                        }
                    }
                }
        } else {
            const int layer = u.pn >> 2, pnn = u.pn & 3;
            const int row0 = wr * 64 + fr, colb = pnn * 256 + wc * 32 + 8 * fq;
#pragma unroll
            for (int ai = 0; ai < 2; ++ai)
#pragma unroll
                for (int m = 0; m < 4; ++m) {
                    const int row = row0 + ai * 128 + m * 16;
                    const float inv = 1.0f / sqrtf(rss0[NTOK + row] * (1.0f / 1024.0f) + EPS);
#pragma unroll
                    for (int bj = 0; bj < 2; ++bj) {
                        float* o = kvraw + ((size_t)layer * 256 + row) * 1024 + colb + bj * 128;
                        *(f32x4*)o = acc[ai][bj][m][0] * inv; *(f32x4*)(o + 4) = acc[ai][bj][m][1] * inv;
                    }
                }
        }
    }
};

__device__ __forceinline__ bf16* kimg_ptr(unsigned char* ws, int layer, int stream, int head) { return (bf16*)(ws + WS_KVIMG) + ((size_t)((layer * 9 + stream) * 4 + head)) * 65536; }
__device__ __forceinline__ bf16* vtimg_ptr(unsigned char* ws, int layer, int stream, int head) { return kimg_ptr(ws, layer, stream, head) + 32768; }
__device__ __forceinline__ void fix_items(Frame& F, int gw, int NGW) {
    const int lane = F.lane;
    for (int it = gw; it < 512; it += NGW) {
        const int layer = it >> 8, m = it & 255;
        const float* src = (const float*)(F.ws + WS_KVRAW) + ((size_t)layer * 256 + m) * 1024 + 16 * lane;
        f32x4 v[4];
#pragma unroll
        for (int j = 0; j < 4; ++j) v[j] = *(const f32x4*)(src + 4 * j);
        const int col = 16 * lane;
        if (col < 512) {
            float s = 0.f;
#pragma unroll
            for (int j = 0; j < 4; ++j) s += (v[j].x * v[j].x + v[j].y * v[j].y) + (v[j].z * v[j].z + v[j].w * v[j].w);
            s += __shfl_xor(s, 1); s += __shfl_xor(s, 2); s += __shfl_xor(s, 4);
            const float inv = 1.0f / sqrtf(s * (1.0f / 128.0f) + EPS);
            const int hd = col >> 7, d0 = col & 127;
            const float* kg = F.inp(14) + layer * 128 + d0; const float* qg = F.inp(13) + layer * 128 + d0;
            float* o = F.out + O_MEMK + ((size_t)layer * 256 + m) * 512 + col;
            bf16* ki = kimg_ptr(F.ws, layer, 0, hd) + (size_t)m * 128 + d0;
            unsigned pw[8];
#pragma unroll
            for (int j = 0; j < 4; ++j) { f32x4 g = *(const f32x4*)(kg + 4 * j), q = *(const f32x4*)(qg + 4 * j); f32x4 r = v[j] * inv * g; *(f32x4*)(o + 4 * j) = r; r = r * q; pw[2 * j] = pk2(r.x, r.y); pw[2 * j + 1] = pk2(r.z, r.w); }
            *(u32x4*)ki = (u32x4){pw[0], pw[1], pw[2], pw[3]}; *(u32x4*)(ki + 8) = (u32x4){pw[4], pw[5], pw[6], pw[7]};
        } else {
            const int c2 = col - 512, hd = c2 >> 7, d0 = c2 & 127;
            float* o = F.out + O_MEMV + ((size_t)layer * 256 + m) * 512 + c2;
            bf16* vt = vtimg_ptr(F.ws, layer, 0, hd);
#pragma unroll
            for (int j = 0; j < 4; ++j) { *(f32x4*)(o + 4 * j) = v[j];
#pragma unroll
                for (int e = 0; e < 4; ++e) vt[(size_t)(d0 + 4 * j + e) * 256 + m] = (bf16)(pk2(v[j][e], 0.f) & 0xffffu); }
        }
    }
    for (int it = gw; it < 4096; it += NGW) {
        const int layer = it >> 11, b = (it >> 8) & 7, m = it & 255;
        const size_t base = (((size_t)layer * 8 + b) * 256 + m) * 512 + 8 * lane;
        const int hd = (8 * lane) >> 7, d0 = (8 * lane) & 127;
        const f32x4 k0 = *(const f32x4*)(F.inp(3) + base), k1 = *(const f32x4*)(F.inp(3) + base + 4);
        const f32x4 v0 = *(const f32x4*)(F.inp(4) + base), v1 = *(const f32x4*)(F.inp(4) + base + 4);
        const float* qg = F.inp(13) + layer * 128 + d0; const f32x4 q0 = *(const f32x4*)qg, q1 = *(const f32x4*)(qg + 4);
        const f32x4 a = k0 * q0, c = k1 * q1;
        *(u32x4*)(kimg_ptr(F.ws, layer, 1 + b, hd) + (size_t)m * 128 + d0) = (u32x4){pk2(a.x, a.y), pk2(a.z, a.w), pk2(c.x, c.y), pk2(c.z, c.w)};
        bf16* vt = vtimg_ptr(F.ws, layer, 1 + b, hd);
#pragma unroll
        for (int e = 0; e < 4; ++e) { vt[(size_t)(d0 + e) * 256 + m] = (bf16)(pk2(v0[e], 0.f) & 0xffffu); vt[(size_t)(d0 + 4 + e) * 256 + m] = (bf16)(pk2(v1[e], 0.f) & 0xffffu); }
    }
    for (int it = gw; it < 1024; it += NGW) {
        const size_t base = (size_t)it * 256 + 4 * lane; const int d0 = (4 * lane) & 63;
        const f32x4 k = *(const f32x4*)(F.inp(7) + base), v = *(const f32x4*)(F.inp(8) + base), q = *(const f32x4*)(F.inp(22) + d0);
        const f32x4 a = k * q;
        bf16* ko = (bf16*)(F.ws + WS_SWAC) + base; bf16* vo = ko + 8 * 128 * 256;
        *(u32x2*)ko = (u32x2){pk2(a.x, a.y), pk2(a.z, a.w)}; *(u32x2*)vo = (u32x2){pk2(v.x, v.y), pk2(v.z, v.w)};
    }
}

constexpr int PREP_HALF = 77824;
constexpr int PR_KT = 0, PR_QT = 17408, PR_VB = 34816, PR_AM = 52224  , PR_BETA = 70464, PR_CUM = 70720, PR_GSC = 70976, PR_G = 71232, PR_CW = 71488  ;
static_assert(2 * PREP_HALF <= MISC_OFF && PR_AM + 18224 <= PR_BETA && PR_CW + 6144 <= PREP_HALF, "prep LDS");
__device__ __forceinline__ void conv8(const LAS bf16* rawp, const LAS float* wp, float (&o)[8]) {
#pragma unroll
    for (int e = 0; e < 8; ++e) o[e] = 0.f;
#pragma unroll
    for (int tap = 0; tap < 4; ++tap) {
        const u32x4 r = *(const LAS u32x4*)(rawp + tap * 136);
        const f32x4 w0 = *(const LAS f32x4*)(wp + tap * 384), w1 = *(const LAS f32x4*)(wp + tap * 384 + 4);
        o[0] += bflo(r.x) * w0.x; o[1] += bfhi(r.x) * w0.y; o[2] += bflo(r.y) * w0.z; o[3] += bfhi(r.y) * w0.w;
        o[4] += bflo(r.z) * w1.x; o[5] += bfhi(r.z) * w1.y; o[6] += bflo(r.w) * w1.z; o[7] += bfhi(r.w) * w1.w;
    }
#pragma unroll
    for (int e = 0; e < 8; ++e) o[e] = silu_f(o[e]);
}
__device__ __forceinline__ int crow32(int g, int hh) { return (g & 3) + 8 * (g >> 2) + 4 * hh; }
__device__ __forceinline__ bf16 f2b(float v) { return (bf16)(pk2(v, 0.f) & 0xffffu); }
__device__ __forceinline__ void prep_load_cw(Frame& F, int hp) {
    const int hw = F.wave >> 2, h = 2 * hp + hw, th = F.tid & 255;
    LAS float* cw = (LAS float*)(F.lds + hw * PREP_HALF + PR_CW);
    for (int p = th; p < 384; p += 256) { const int tap = p / 96, rem = p - tap * 96, part = rem >> 5, c4 = rem & 31;
        *(LAS f32x4*)(cw + tap * 384 + part * 128 + 4 * c4) = *(const f32x4*)(F.inp(16) + (size_t)tap * 3072 + part * 1024 + 128 * h + 4 * c4); }
}
__device__ __forceinline__ void prep_unit(Frame& F, int cid, int hp) {
    const int hw = F.wave >> 2, h = 2 * hp + hw, th = F.tid & 255, wv = F.wave & 3, lane = F.lane;
    LAS unsigned char* L = F.lds + hw * PREP_HALF;
    LAS bf16* raw = (LAS bf16*)(L + PR_AM);
    LAS bf16* kt = (LAS bf16*)(L + PR_KT); LAS bf16* qt = (LAS bf16*)(L + PR_QT); LAS bf16* vb = (LAS bf16*)(L + PR_VB);
    LAS float* Am = (LAS float*)(L + PR_AM);
    LAS float* beta = (LAS float*)(L + PR_BETA); LAS float* cum = (LAS float*)(L + PR_CUM); LAS float* gsc = (LAS float*)(L + PR_GSC);
    const LAS float* cwl = (const LAS float*)(L + PR_CW);
    bf16* bigrow = F.big + (size_t)cid * 64 * PITCH;
    if (th < 64) {
        const float* bap = (const float*)(F.ws + WS_BA) + ((size_t)cid * 64 + th) * 16;
        const float braw = bap[h], araw = bap[8 + h];
        const float x = araw + F.inp(18)[h];
        const float sp = (x > 20.f) ? x : log1pf(__expf(x));
        float c = -__expf(F.inp(17)[h]) * sp;
        const float bt = 1.0f / (1.0f + __expf(-braw));
#pragma unroll
        for (int o = 1; o < 64; o <<= 1) { const float t = __shfl_up(c, o); if (lane >= o) c += t; }
        beta[th] = bt; cum[th] = c; gsc[th] = bt * __expf(c);
    }
    const int i = th >> 2, seg = th & 3;
#pragma unroll 1
    for (int part = 0; part < 3; ++part) {
        const int colg = part * 1024 + 128 * h;
        {
            u32x4 v[4];
#pragma unroll
            for (int k = 0; k < 4; ++k) { const int p = th + 256 * k; v[k] = *(const u32x4*)(bigrow + (unsigned)((p >> 4) * PITCH + colg + 8 * (p & 15))); }
            if (th < 48) {
                const int j = th >> 4, col = colg + 8 * (th & 15); u32x4 hv;
                if (cid == 0) hv = (u32x4){0u, 0u, 0u, 0u};
                else if (cid < 256) hv = *(const u32x4*)((const bf16*)(F.ws + WS_HALO) + ((size_t)(cid - 1) * 3 + j) * 3072 + col);
                else { const float* sp = F.inp(6) + ((size_t)(cid - 256) * 3 + j) * 3072 + col; const f32x4 a = *(const f32x4*)sp, b = *(const f32x4*)(sp + 4);
                       hv = (u32x4){pk2(a.x, a.y), pk2(a.z, a.w), pk2(b.x, b.y), pk2(b.z, b.w)}; }
                *(LAS u32x4*)(raw + j * 136 + 8 * (th & 15)) = hv;
            }
#pragma unroll
            for (int k = 0; k < 4; ++k) { const int p = th + 256 * k; *(LAS u32x4*)(raw + ((p >> 4) + 3) * 136 + 8 * (p & 15)) = v[k]; }
        }
        __syncthreads();
        float xv[32];
#pragma unroll
        for (int g8 = 0; g8 < 4; ++g8) {
            float o[8];
            conv8(raw + i * 136 + seg * 32 + g8 * 8, cwl + part * 128 + seg * 32 + g8 * 8, o);
#pragma unroll
            for (int e = 0; e < 8; ++e) xv[g8 * 8 + e] = o[e];
            asm volatile("" ::: "memory");
        }
        float sc;
        if (part < 2) {
            float ss = 0.f;
#pragma unroll
            for (int e = 0; e < 32; ++e) ss += xv[e] * xv[e];
            ss += __shfl_xor(ss, 1); ss += __shfl_xor(ss, 2);
            sc = 1.0f / sqrtf(ss + EPS); if (part == 0) sc *= 0.08838834764831845f;
        } else sc = beta[i];
        LAS bf16* dst = (part == 0 ? qt : (part == 1 ? kt : vb)) + i * 136 + seg * 32;
#pragma unroll
        for (int g8 = 0; g8 < 4; ++g8)
            *(LAS u32x4*)(dst + g8 * 8) = (u32x4){pk2(xv[g8*8+0] * sc, xv[g8*8+1] * sc), pk2(xv[g8*8+2] * sc, xv[g8*8+3] * sc), pk2(xv[g8*8+4] * sc, xv[g8*8+5] * sc), pk2(xv[g8*8+6] * sc, xv[g8*8+7] * sc)};
        __syncthreads();
    }
    bf16* qx = (bf16*)F.out + (size_t)(cid * 8 + h) * 12288;
    {
        const int ti = wv >> 1, tj = wv & 1, r = lane & 31, hh = lane >> 5;
        f32x16 kk, qk;
#pragma unroll
        for (int g = 0; g < 16; ++g) { kk[g] = 0.f; qk[g] = 0.f; }
#pragma unroll
        for (int s = 0; s < 8; ++s) {
            const bf16x8 a = *(const LAS bf16x8*)(kt + (32 * ti + r) * 136 + 16 * s + 8 * hh);
            const bf16x8 q = *(const LAS bf16x8*)(qt + (32 * ti + r) * 136 + 16 * s + 8 * hh);
            const bf16x8 b = *(const LAS bf16x8*)(kt + (32 * tj + r) * 136 + 16 * s + 8 * hh);
            kk = __builtin_amdgcn_mfma_f32_32x32x16_bf16(a, b, kk, 0, 0, 0);
            qk = __builtin_amdgcn_mfma_f32_32x32x16_bf16(b, q, qk, 0, 0, 0);
        }
        {
            const int j = 32 * tj + r; const float cj = cum[j];
#pragma unroll
            for (int g = 0; g < 16; ++g) {
                int hh_ = hh; asm volatile("" : "+v"(hh_));
                const int ii = 32 * ti + crow32(g, hh_);
                const float dec = __expf(fminf(cum[ii] - cj, 0.f));
                Am[ii * 68 + j] = (ii > j) ? beta[ii] * kk[g] * dec : 0.f;
            }
        }
        {
            const int ii = 32 * ti + r; const float ci = cum[ii];
#pragma unroll
            for (int a4 = 0; a4 < 4; ++a4) {
                int hh_ = hh; asm volatile("" : "+v"(hh_));
                const int j0 = 32 * tj + 8 * a4 + 4 * hh_; float v[4];
#pragma unroll
                for (int e = 0; e < 4; ++e) { const int j = j0 + e; v[e] = (ii >= j) ? qk[4 * a4 + e] * __expf(fminf(ci - cum[j], 0.f)) : 0.f; }
                *(u32x2*)(qx + (unsigned)(8192 + ii * 64 + (((j0 >> 3) ^ ((ii >> 1) & 7)) << 3) + (j0 & 7))) = (u32x2){pk2(v[0], v[1]), pk2(v[2], v[3])};
            }
        }
    }
    {
        const float clast = cum[63];
        bf16* kbase = bigrow + 1024 + 128 * h;
#pragma unroll
        for (int pp = 0; pp < 4; ++pp) {
            const int p = th + 256 * pp, kk = p >> 3, c16 = p & 7;
            float v[8];
#pragma unroll
            for (int e = 0; e < 8; ++e) { const int ii = 8 * c16 + e; v[e] = bf2f(kt[ii * 136 + kk]) * __expf(clast - cum[ii]); }
            const int e0 = kk * 64 + ((c16 ^ ((kk >> 1) & 7)) << 3);
            *(u32x4*)(kbase + (unsigned)((e0 >> 7) * PITCH + (e0 & 127))) = (u32x4){pk2(v[0], v[1]), pk2(v[2], v[3]), pk2(v[4], v[5]), pk2(v[6], v[7])};
        }
#pragma unroll
        for (int pp = 0; pp < 4; ++pp) {
            const int p = th + 256 * pp, ii = p >> 4, c16 = p & 15;
            const u32x4 r = *(const LAS u32x4*)(qt + ii * 136 + 8 * c16); const float ec = __expf(cum[ii]);
            *(u32x4*)(qx + (unsigned)(ii * 128 + ((c16 ^ (ii & 15)) << 3))) = (u32x4){pk2(bflo(r.x) * ec, bfhi(r.x) * ec), pk2(bflo(r.y) * ec, bfhi(r.y) * ec), pk2(bflo(r.z) * ec, bfhi(r.z) * ec), pk2(bflo(r.w) * ec, bfhi(r.w) * ec)};
        }
        if (th == 0) ((float*)(F.ws + WS_ACHUNK))[cid * 8 + h] = __expf(clast);
    }
    {
        const int c = th;
        float sol[64];
        {
            const LAS bf16* rp = (c < 128) ? (vb + c) : (kt + (c - 128));
#pragma unroll
            for (int ii = 0; ii < 64; ++ii) { float v = bf2f(rp[ii * 136]); if (c >= 128) v *= gsc[ii]; sol[ii] = v; }
        }
        __syncthreads();
        LAS bf16* wblob = qt; LAS bf16* ublob = vb;
        const int w = c >> 4, col = c & 15, kk = c - 128;
#pragma unroll
        for (int ii = 0; ii < 64; ++ii) {
            float v0 = 0.f, v1 = 0.f, v2 = 0.f, v3 = 0.f;
#pragma unroll
            for (int j4 = 0; j4 < (ii + 3) / 4; ++j4) {
                const f32x4 a = *(const LAS f32x4*)(Am + ii * 68 + 4 * j4);
                v0 += a.x * sol[4 * j4];
                if (4 * j4 + 1 < ii) v1 += a.y * sol[4 * j4 + 1];
                if (4 * j4 + 2 < ii) v2 += a.z * sol[4 * j4 + 2];
                if (4 * j4 + 3 < ii) v3 += a.w * sol[4 * j4 + 3];
            }
            const float v = sol[ii] - ((v0 + v1) + (v2 + v3));
            sol[ii] = v;
            int kk_ = kk, col_ = col; asm volatile("" : "+v"(kk_), "+v"(col_));
            if (c >= 128) wblob[ii * 128 + ((((kk_ >> 3) ^ (ii & 15)) << 3) + (kk_ & 7))] = f2b(v);
            else if ((ii & 3) == 3) { const int t4 = ii >> 4, q = (ii >> 2) & 3; *(LAS u32x2*)(ublob + (((w * 4 + t4) * 4 + q) * 16 + col_) * 4) = (u32x2){pk2(sol[ii - 3], sol[ii - 2]), pk2(sol[ii - 1], sol[ii])}; }
            asm volatile("" ::: "memory");
        }
    }
    __syncthreads();
    {
        bf16* wbase = bigrow + 128 * h; bf16* vbase = bigrow + 2048 + 128 * h;
#pragma unroll
        for (int pp = 0; pp < 4; ++pp) {
            const int p = th + 256 * pp;
            *(u32x4*)(wbase + (unsigned)((p >> 4) * PITCH + 8 * (p & 15))) = *(const LAS u32x4*)(qt + 8 * p);
            *(u32x4*)(vbase + (unsigned)((p >> 4) * PITCH + 8 * (p & 15))) = *(const LAS u32x4*)(vb + 8 * p);
        }
    }
    __syncthreads();
}

constexpr int EN_STAGE = 57344, EN_W = 0, EN_KDT = 16384, EN_QD = 32768, EN_QK = 49152, EN_SSQ = 2 * EN_STAGE, EN_TILE = EN_SSQ + 512;
static_assert(EN_TILE + 2 * 16384 <= MISC_OFF, "engine LDS");
__device__ __forceinline__ void en_stage(Frame& F, int cid, int h, int st) {
    const bf16* big = F.big; const int lane = F.lane;
#pragma unroll
    for (int k = 0; k < 7; ++k) {
        const int piece = F.wave + 8 * k;
        const char* g;
        if (piece < 32) { const int o = (piece & 15) * 1024 + lane * 16; g = (const char*)(big + ((size_t)cid * 64 + (o >> 8)) * PITCH + (piece < 16 ? 0 : 1024) + 128 * h) + (o & 255); }
        else g = (const char*)((const bf16*)F.out + (size_t)(cid * 8 + h) * 12288) + (piece - 32) * 1024 + lane * 16;
        __builtin_amdgcn_global_load_lds((const unsigned*)g, (LAS unsigned*)(F.lds + st * EN_STAGE + piece * 1024), 16, 0, 0);
    }
}
__device__ __forceinline__ void en_ztile(Frame& F, int cid, int h, int tb) {
#pragma unroll
    for (int k = 0; k < 2; ++k) { const int piece = F.wave + 8 * k; const int o = piece * 1024 + F.lane * 16;
        const char* g = (const char*)(F.big + ((size_t)cid * 64 + (o >> 8)) * PITCH + C_Z + 128 * h) + (o & 255);
        __builtin_amdgcn_global_load_lds((const unsigned*)g, (LAS unsigned*)(F.lds + EN_TILE + tb * 16384 + piece * 1024), 16, 0, 0); }
}
__device__ __forceinline__ bf16x8 pack2(const f32x4& a, const f32x4& b) { u32x4 p = {pk2(a.x, a.y), pk2(a.z, a.w), pk2(b.x, b.y), pk2(b.z, b.w)}; return __builtin_bit_cast(bf16x8, p); }
__device__ __forceinline__ bf16x8 ld_frag(const LAS unsigned char* p0, const LAS unsigned char* p1) { const u32x2 a = *(const LAS u32x2*)p0, b = *(const LAS u32x2*)p1; u32x4 p = {a.x, a.y, b.x, b.y}; return __builtin_bit_cast(bf16x8, p); }
#define MFMA16(a, b, c) __builtin_amdgcn_mfma_f32_16x16x32_bf16((a), (b), (c), 0, 0, 0)
__device__ __forceinline__ void gdn_scan(Frame& F, int cid0, int n, int h, const float* hinit, bool hinit_blob, float* hfinal) {
    const int w = F.wave; int lane = F.lane, col = lane & 15, q = lane >> 4;
    bf16* big = F.big;
    LAS float* ssq = (LAS float*)(F.lds + EN_SSQ);
    f32x4 hS[8];
#pragma unroll
    for (int t = 0; t < 8; ++t) {
        if (hinit && hinit_blob) hS[t] = *(const f32x4*)(hinit + w * 2048 + ((t * 4 + q) * 16 + col) * 4);
        else if (hinit) { const float* p = hinit + (size_t)(16 * t + 4 * q) * 128 + 16 * w + col; hS[t] = (f32x4){p[0], p[128], p[256], p[384]}; }
        else hS[t] = (f32x4){0.f, 0.f, 0.f, 0.f};
    }
    if (F.tid < 128) ssq[F.tid] = 0.f;
    const float og = F.inp(19)[16 * w + col];
    u32x2 un[4];
    en_stage(F, cid0, h, 0); en_ztile(F, cid0, h, 0);
#pragma unroll
    for (int t4 = 0; t4 < 4; ++t4) { const int e = (((w * 4 + t4) * 4 + q) * 16 + col) * 4; un[t4] = *(const u32x2*)(big + ((size_t)cid0 * 64 + (e >> 7)) * PITCH + 2048 + 128 * h + (e & 127)); }
    float ach_n = ((const float*)(F.ws + WS_ACHUNK))[cid0 * 8 + h];
    for (int s = 0; s < n; ++s) {
        const int cid = cid0 + s, st = s & 1;
        asm volatile("" : "+v"(lane)); col = lane & 15; q = lane >> 4;
        const int b128 = col * 256 + (q & 1) * 8 + (((q >> 1) ^ col) << 4), b64 = col * 128 + (q & 1) * 8 + (((q >> 1) ^ ((col >> 1) & 7)) << 4);
        VM_WAIT(); __syncthreads();
        if (s > 0) {
            const LAS bf16* tp = (const LAS bf16*)(F.lds + EN_TILE + (st ^ 1) * 16384);
#pragma unroll
            for (int k = 0; k < 2; ++k) { const int p = F.tid + 512 * k; *(u32x4*)(big + ((size_t)(cid - 1) * 64 + (p >> 4)) * PITCH + C_Z + 128 * h + 8 * (p & 15)) = *(const LAS u32x4*)(tp + 8 * p); }
        }
        f32x4 u[4];
#pragma unroll
        for (int t4 = 0; t4 < 4; ++t4) u[t4] = (f32x4){bflo(un[t4].x), bfhi(un[t4].x), bflo(un[t4].y), bfhi(un[t4].y)};
        u32x4 zreg[2];
        if (s + 1 < n) {
#pragma unroll
            for (int k = 0; k < 2; ++k) { const int p = F.tid + 512 * k; zreg[k] = *(const u32x4*)(big + ((size_t)(cid + 1) * 64 + (p >> 4)) * PITCH + C_Z + 128 * h + 8 * (p & 15)); }
            en_stage(F, cid + 1, h, st ^ 1);
#pragma unroll
            for (int t4 = 0; t4 < 4; ++t4) { const int e = (((w * 4 + t4) * 4 + q) * 16 + col) * 4; un[t4] = *(const u32x2*)(big + ((size_t)(cid + 1) * 64 + (e >> 7)) * PITCH + 2048 + 128 * h + (e & 127)); }
        }
        if (F.tid < 64) ssq[(st ^ 1) * 64 + F.tid] = 0.f;
        const LAS unsigned char* SB = F.lds + st * EN_STAGE;
        const float ach = ach_n; if (s + 1 < n) ach_n = ((const float*)(F.ws + WS_ACHUNK))[(cid + 1) * 8 + h];
        bf16x8 hB[4];
#pragma unroll
        for (int ks = 0; ks < 4; ++ks) hB[ks] = pack2(hS[2 * ks], hS[2 * ks + 1]);
        f32x4 vn[4], o[4];
#pragma unroll
        for (int t4 = 0; t4 < 4; ++t4) {
            const int row = 16 * t4 + col; f32x4 a = {0.f, 0.f, 0.f, 0.f}, b = {0.f, 0.f, 0.f, 0.f};
#pragma unroll
            for (int ks = 0; ks < 4; ++ks) {
                const int off0 = (b128 ^ ((4 * ks) << 4)) + (row >> 4) * 4096, off1 = (b128 ^ ((4 * ks + 2) << 4)) + (row >> 4) * 4096;
                a = MFMA16(ld_frag(SB + EN_W + off0, SB + EN_W + off1), hB[ks], a);
                b = MFMA16(ld_frag(SB + EN_QD + off0, SB + EN_QD + off1), hB[ks], b);
            }
            vn[t4] = u[t4] - a; o[t4] = b;
        }
        bf16x8 vB[2];
        vB[0] = pack2(vn[0], vn[1]); vB[1] = pack2(vn[2], vn[3]);
#pragma unroll
        for (int t4 = 0; t4 < 4; ++t4) {
            const int row = 16 * t4 + col;
#pragma unroll
            for (int cs = 0; cs < 2; ++cs) {
                if (32 * cs > 16 * t4 + 15) continue;
                const int off0 = (b64 ^ ((4 * cs) << 4)) + (row >> 4) * 2048, off1 = (b64 ^ ((4 * cs + 2) << 4)) + (row >> 4) * 2048;
                o[t4] = MFMA16(ld_frag(SB + EN_QK + off0, SB + EN_QK + off1), vB[cs], o[t4]);
            }
        }
#pragma unroll
        for (int t = 0; t < 8; ++t) {
            const int row = 16 * t + col; f32x4 a = hS[t] * ach;
#pragma unroll
            for (int cs = 0; cs < 2; ++cs) {
                const int off0 = (b64 ^ ((4 * cs) << 4)) + (row >> 4) * 2048, off1 = (b64 ^ ((4 * cs + 2) << 4)) + (row >> 4) * 2048;
                a = MFMA16(ld_frag(SB + EN_KDT + off0, SB + EN_KDT + off1), vB[cs], a);
            }
            hS[t] = a;
        }
#pragma unroll
        for (int t4 = 0; t4 < 4; ++t4)
#pragma unroll
            for (int r = 0; r < 4; ++r) {
                float v = o[t4][r] * o[t4][r];
                v += __shfl_xor(v, 1); v += __shfl_xor(v, 2); v += __shfl_xor(v, 4); v += __shfl_xor(v, 8);
                if (col == 0) atomicAdd((float*)(ssq + st * 64 + 16 * t4 + 4 * q + r), v);
            }
        LAS bf16* tile = (LAS bf16*)(F.lds + EN_TILE + st * 16384);
        __syncthreads();
        if (s + 1 < n) {
            LAS bf16* tn = (LAS bf16*)(F.lds + EN_TILE + (st ^ 1) * 16384);
#pragma unroll
            for (int k = 0; k < 2; ++k) { const int p = F.tid + 512 * k; *(LAS u32x4*)(tn + 8 * p) = zreg[k]; }
        }
#pragma unroll
        for (int t4 = 0; t4 < 4; ++t4)
#pragma unroll
            for (int r = 0; r < 4; ++r) {
                const int row = 16 * t4 + 4 * q + r;
                const float inv = 1.0f / sqrtf(ssq[st * 64 + row] * (1.0f / 128.0f) + EPS);
                LAS bf16* zp = tile + row * 128 + 16 * w + col;
                const float z = bf2f(*zp);
                *zp = f2b(o[t4][r] * inv * og * silu_f(z));
            }
    }
    __syncthreads();
    {
        const LAS bf16* tp = (const LAS bf16*)(F.lds + EN_TILE + ((n - 1) & 1) * 16384);
#pragma unroll
        for (int k = 0; k < 2; ++k) { const int p = F.tid + 512 * k; *(u32x4*)(big + ((size_t)(cid0 + n - 1) * 64 + (p >> 4)) * PITCH + C_Z + 128 * h + 8 * (p & 15)) = *(const LAS u32x4*)(tp + 8 * p); }
    }
    if (hfinal) {
#pragma unroll
        for (int t = 0; t < 8; ++t) { float* p = hfinal + (size_t)(16 * t + 4 * q) * 128 + 16 * w + col; p[0] = hS[t].x; p[128] = hS[t].y; p[256] = hS[t].z; p[384] = hS[t].w; }
    }
    __syncthreads();
}

__device__ __forceinline__ void en_stage1(Frame& F, int cid, int h, int st) {
    const bf16* big = F.big; const int lane = F.lane;
#pragma unroll
    for (int k = 0; k < 4; ++k) {
        const int piece = F.wave + 8 * k; const int o = (piece & 15) * 1024 + lane * 16;
        const char* g = (const char*)(big + ((size_t)cid * 64 + (o >> 8)) * PITCH + (piece < 16 ? 0 : 1024) + 128 * h) + (o & 255);
        __builtin_amdgcn_global_load_lds((const unsigned*)g, (LAS unsigned*)(F.lds + st * 32768 + piece * 1024), 16, 0, 0);
    }
}
__device__ __forceinline__ void gdn_l1(Frame& F, int g, int h) {
    const int w = F.wave, lane = F.lane, col = lane & 15, q = lane >> 4, cid0 = 8 * g;
    const int b128 = col * 256 + (q & 1) * 8 + (((q >> 1) ^ col) << 4), b64 = col * 128 + (q & 1) * 8 + (((q >> 1) ^ ((col >> 1) & 7)) << 4);
    const bf16* big = F.big;
    f32x4 hB[8], hP[8];
#pragma unroll
    for (int t = 0; t < 8; ++t) { hB[t] = (f32x4){0.f, 0.f, 0.f, 0.f};
#pragma unroll
        for (int r = 0; r < 4; ++r) hP[t][r] = (16 * t + 4 * q + r == 16 * w + col) ? 1.f : 0.f; }
    u32x2 un[4];
    en_stage1(F, cid0, h, 0);
#pragma unroll
    for (int t4 = 0; t4 < 4; ++t4) { const int e = (((w * 4 + t4) * 4 + q) * 16 + col) * 4; un[t4] = *(const u32x2*)(big + ((size_t)cid0 * 64 + (e >> 7)) * PITCH + 2048 + 128 * h + (e & 127)); }
    float ach_n = ((const float*)(F.ws + WS_ACHUNK))[cid0 * 8 + h];
#pragma unroll 1
    for (int s = 0; s < 8; ++s) {
        const int cid = cid0 + s, st = s & 1;
        VM_WAIT(); __syncthreads();
        f32x4 u[4];
#pragma unroll
        for (int t4 = 0; t4 < 4; ++t4) u[t4] = (f32x4){bflo(un[t4].x), bfhi(un[t4].x), bflo(un[t4].y), bfhi(un[t4].y)};
        if (s + 1 < 8) {
            en_stage1(F, cid + 1, h, st ^ 1);
#pragma unroll
            for (int t4 = 0; t4 < 4; ++t4) { const int e = (((w * 4 + t4) * 4 + q) * 16 + col) * 4; un[t4] = *(const u32x2*)(big + ((size_t)(cid + 1) * 64 + (e >> 7)) * PITCH + 2048 + 128 * h + (e & 127)); }
        }
        const LAS unsigned char* SB = F.lds + st * 32768;
        const float ach = ach_n; if (s + 1 < 8) ach_n = ((const float*)(F.ws + WS_ACHUNK))[(cid + 1) * 8 + h];
        bf16x8 fB[4], fP[4];
#pragma unroll
        for (int ks = 0; ks < 4; ++ks) { fB[ks] = pack2(hB[2 * ks], hB[2 * ks + 1]); fP[ks] = pack2(hP[2 * ks], hP[2 * ks + 1]); }
        f32x4 vnB[4], vnP[4];
#pragma unroll
        for (int t4 = 0; t4 < 4; ++t4) {
            const int row = 16 * t4 + col; f32x4 a = {0.f, 0.f, 0.f, 0.f}, b = {0.f, 0.f, 0.f, 0.f};
#pragma unroll
            for (int ks = 0; ks < 4; ++ks) {
                const int off0 = (b128 ^ ((4 * ks) << 4)) + (row >> 4) * 4096, off1 = (b128 ^ ((4 * ks + 2) << 4)) + (row >> 4) * 4096;
                const bf16x8 wf = ld_frag(SB + off0, SB + off1);
                a = MFMA16(wf, fB[ks], a); b = MFMA16(wf, fP[ks], b);
            }
            vnB[t4] = u[t4] - a; vnP[t4] = -b;
            asm volatile("" ::: "memory");
        }
        bf16x8 vB[2], vP[2];
        vB[0] = pack2(vnB[0], vnB[1]); vB[1] = pack2(vnB[2], vnB[3]); vP[0] = pack2(vnP[0], vnP[1]); vP[1] = pack2(vnP[2], vnP[3]);
#pragma unroll
        for (int t = 0; t < 8; ++t) {
            const int row = 16 * t + col; f32x4 a = hB[t] * ach, b = hP[t] * ach;
#pragma unroll
            for (int cs = 0; cs < 2; ++cs) {
                const int off0 = (b64 ^ ((4 * cs) << 4)) + (row >> 4) * 2048, off1 = (b64 ^ ((4 * cs + 2) << 4)) + (row >> 4) * 2048;
                const bf16x8 kf = ld_frag(SB + 16384 + off0, SB + 16384 + off1);
                a = MFMA16(kf, vB[cs], a); b = MFMA16(kf, vP[cs], b);
            }
            hB[t] = a; hP[t] = b;
            asm volatile("" ::: "memory");
        }
    }
    float* hs = (float*)(F.ws + WS_HSLOT) + ((size_t)g * 8 + h) * 16384;
    bf16* mg = (bf16*)(F.ws + WS_MG) + ((size_t)g * 8 + h) * 16384;
#pragma unroll
    for (int t = 0; t < 8; ++t) {
        int q_ = q, col_ = col; asm volatile("" : "+v"(q_), "+v"(col_));
        *(f32x4*)(hs + (unsigned)(w * 2048 + ((t * 4 + q_) * 16 + col_) * 4)) = hB[t];
#pragma unroll
        for (int r = 0; r < 4; ++r) { const int i = 16 * t + 4 * q_ + r, kk = 16 * w + col_; mg[(unsigned)(i * 128 + ((((kk >> 3) ^ (i & 15)) << 3) + (kk & 7)))] = f2b(hP[t][r]); }
        asm volatile("" ::: "memory");
    }
    __syncthreads();
}
__device__ __forceinline__ void en_stage2(Frame& F, int g, int h, int st) {
    const char* src = (const char*)((const bf16*)(F.ws + WS_MG) + ((size_t)g * 8 + h) * 16384);
#pragma unroll
    for (int k = 0; k < 4; ++k) { const int piece = F.wave + 8 * k;
        __builtin_amdgcn_global_load_lds((const unsigned*)(src + piece * 1024 + F.lane * 16), (LAS unsigned*)(F.lds + st * 32768 + piece * 1024), 16, 0, 0); }
}
__device__ __forceinline__ void gdn_l2(Frame& F, int h, float* hfinal) {
    const int w = F.wave, lane = F.lane, col = lane & 15, q = lane >> 4;
    const int b128 = col * 256 + (q & 1) * 8 + (((q >> 1) ^ col) << 4);
    f32x4 hS[8], bn[8];
#pragma unroll
    for (int t = 0; t < 8; ++t) hS[t] = (f32x4){0.f, 0.f, 0.f, 0.f};
    en_stage2(F, 0, h, 0);
    {
        const float* hs = (const float*)(F.ws + WS_HSLOT) + (size_t)h * 16384;
#pragma unroll
        for (int t = 0; t < 8; ++t) bn[t] = *(const f32x4*)(hs + w * 2048 + ((t * 4 + q) * 16 + col) * 4);
    }
#pragma unroll 1
    for (int g = 0; g < 32; ++g) {
        const int st = g & 1;
        VM_WAIT(); __syncthreads();
        f32x4 acc[8];
#pragma unroll
        for (int t = 0; t < 8; ++t) acc[t] = bn[t];
        float* hs = (float*)(F.ws + WS_HSLOT) + ((size_t)g * 8 + h) * 16384;
        if (g + 1 < 32) {
            en_stage2(F, g + 1, h, st ^ 1);
            const float* hn = hs + 8 * 16384;
#pragma unroll
            for (int t = 0; t < 8; ++t) bn[t] = *(const f32x4*)(hn + w * 2048 + ((t * 4 + q) * 16 + col) * 4);
        }
        const LAS unsigned char* SB = F.lds + st * 32768;
        bf16x8 fB[4];
#pragma unroll
        for (int ks = 0; ks < 4; ++ks) fB[ks] = pack2(hS[2 * ks], hS[2 * ks + 1]);
#pragma unroll
        for (int t = 0; t < 8; ++t) {
            const int row = 16 * t + col; f32x4 a = acc[t];
#pragma unroll
            for (int ks = 0; ks < 4; ++ks) {
                const int off0 = (b128 ^ ((4 * ks) << 4)) + (row >> 4) * 4096, off1 = (b128 ^ ((4 * ks + 2) << 4)) + (row >> 4) * 4096;
                a = MFMA16(ld_frag(SB + off0, SB + off1), fB[ks], a);
            }
            hS[t] = a;
            *(f32x4*)(hs + w * 2048 + ((t * 4 + q) * 16 + col) * 4) = a;
        }
    }
#pragma unroll
    for (int t = 0; t < 8; ++t) { float* p = hfinal + (size_t)(16 * t + 4 * q) * 128 + 16 * w + col; p[0] = hS[t].x; p[128] = hS[t].y; p[256] = hS[t].z; p[384] = hS[t].w; }
    __syncthreads();
}

#define MFMA32(a, b, c) __builtin_amdgcn_mfma_f32_32x32x16_bf16((a), (b), (c), 0, 0, 0)
template <int HD, int NKT, int KP, int VP>
__device__ __forceinline__ void attn_core(const LAS bf16* Ks, const LAS bf16* Vs, bf16* qrow, float scale, float sink, bool has_sink, int lo, int lane) {
    const int r = lane & 31, hh = lane >> 5;
    constexpr int NS = HD / 16, NDT = HD / 32;
    bf16x8 qf[NS]; float ss = 0.f;
#pragma unroll
    for (int s = 0; s < NS; ++s) {
        const u32x4 v = *(const u32x4*)(qrow + 16 * s + 8 * hh); qf[s] = __builtin_bit_cast(bf16x8, v);
        ss += bflo(v.x) * bflo(v.x) + bfhi(v.x) * bfhi(v.x) + bflo(v.y) * bflo(v.y) + bfhi(v.y) * bfhi(v.y) + bflo(v.z) * bflo(v.z) + bfhi(v.z) * bfhi(v.z) + bflo(v.w) * bflo(v.w) + bfhi(v.w) * bfhi(v.w);
    }
    ss += __shfl_xor(ss, 32);
    const float inv = (1.0f / sqrtf(ss * (1.0f / HD) + EPS)) * scale;
    float m = -INFINITY;
#pragma unroll 1
    for (int kt = 0; kt < NKT; ++kt) {
        f32x16 acc;
#pragma unroll
        for (int g = 0; g < 16; ++g) acc[g] = 0.f;
#pragma unroll
        for (int s = 0; s < NS; ++s) acc = MFMA32(*(const LAS bf16x8*)(Ks + (32 * kt + r) * KP + 16 * s + 8 * hh), qf[s], acc);
#pragma unroll
        for (int g = 0; g < 16; ++g) { const int key = 32 * kt + crow32(g, hh); float v = acc[g] * inv; if (key < lo) v = -INFINITY; m = fmaxf(m, v); }
    }
    m = fmaxf(m, __shfl_xor(m, 32)); if (has_sink) m = fmaxf(m, sink);
    float l = 0.f;
    f32x16 O[NDT];
#pragma unroll
    for (int dt = 0; dt < NDT; ++dt)
#pragma unroll
        for (int g = 0; g < 16; ++g) O[dt][g] = 0.f;
#pragma unroll 1
    for (int kt = 0; kt < NKT; ++kt) {
        f32x16 acc;
#pragma unroll
        for (int g = 0; g < 16; ++g) acc[g] = 0.f;
#pragma unroll
        for (int s = 0; s < NS; ++s) acc = MFMA32(*(const LAS bf16x8*)(Ks + (32 * kt + r) * KP + 16 * s + 8 * hh), qf[s], acc);
#pragma unroll
        for (int g = 0; g < 16; ++g) { const int key = 32 * kt + crow32(g, hh); float v = acc[g] * inv; if (key < lo) v = -INFINITY; const float pe = __expf(v - m); acc[g] = pe; l += pe; }
#pragma unroll
        for (int st = 0; st < 2; ++st) {
            const u32x4 pw = {pk2(acc[8 * st], acc[8 * st + 1]), pk2(acc[8 * st + 2], acc[8 * st + 3]), pk2(acc[8 * st + 4], acc[8 * st + 5]), pk2(acc[8 * st + 6], acc[8 * st + 7])};
            const bf16x8 pf = __builtin_bit_cast(bf16x8, pw);
#pragma unroll
            for (int dt = 0; dt < NDT; ++dt) {
                const LAS bf16* vp = Vs + (32 * dt + r) * VP + 32 * kt + 16 * st + 4 * hh;
                O[dt] = MFMA32(ld_frag((const LAS unsigned char*)vp, (const LAS unsigned char*)(vp + 8)), pf, O[dt]);
            }
        }
    }
    l += __shfl_xor(l, 32); if (has_sink) l += __expf(sink - m);
    const float rl = 1.0f / l;
#pragma unroll
    for (int dt = 0; dt < NDT; ++dt)
#pragma unroll
        for (int a4 = 0; a4 < 4; ++a4)
            *(u32x2*)(qrow + 32 * dt + 8 * a4 + 4 * hh) = (u32x2){pk2(O[dt][4 * a4] * rl, O[dt][4 * a4 + 1] * rl), pk2(O[dt][4 * a4 + 2] * rl, O[dt][4 * a4 + 3] * rl)};
}
__device__ __forceinline__ void mem_attn_unit(Frame& F, int layer, int u, int qcol) {
    const int hd = u & 3; int stream, row0, nrows;
    if (u < 256) { stream = 0; row0 = (u >> 2) * 256; nrows = 256; } else { const int b = (u - 256) >> 2; stream = 1 + b; row0 = SEQ + 64 * b; nrows = 64; }
    LAS bf16* Ks = (LAS bf16*)F.lds; LAS bf16* Vs = (LAS bf16*)(F.lds + 69632);
    const bf16* kg = kimg_ptr(F.ws, layer, stream, hd); const bf16* vg = kg + 32768;
    for (int p = F.tid; p < 4096; p += 512) { const int row = p >> 4, c = p & 15; *(LAS u32x4*)(Ks + row * 136 + 8 * c) = *(const u32x4*)(kg + row * 128 + 8 * c); }
    for (int p = F.tid; p < 4096; p += 512) { const int d = p >> 5, c = p & 31; const u32x4 v = *(const u32x4*)(vg + d * 256 + 8 * c);
        *(LAS u32x2*)(Vs + d * 260 + 8 * c) = (u32x2){v.x, v.y}; *(LAS u32x2*)(Vs + d * 260 + 8 * c + 4) = (u32x2){v.z, v.w}; }
    __syncthreads();
    if (32 * F.wave < nrows) {
        bf16* qrow = F.big + (size_t)(row0 + 32 * F.wave + (F.lane & 31)) * PITCH + qcol + 128 * hd;
        attn_core<128, 8, 136, 260>(Ks, Vs, qrow, 0.08838834764831845f, 0.f, false, 0, F.lane);
    }
    __syncthreads();
}
__device__ __forceinline__ void swa_unit(Frame& F, int cid, int kvh) {
    LAS bf16* Ks = (LAS bf16*)F.lds; LAS bf16* Vs = (LAS bf16*)(F.lds + 27648);
    const bool sample = cid >= 256; const int b = cid - 256;
    const float* kgain = F.inp(23); const float* qgain = F.inp(22);
    for (int p = F.tid; p < 1536; p += 512) {
        const int t = p >> 3, c8 = p & 7, d0 = 8 * c8;
        u32x4 kw = {0u, 0u, 0u, 0u}, vw = {0u, 0u, 0u, 0u};
        if (sample && t < 128) {
            const bf16* kc = (const bf16*)(F.ws + WS_SWAC) + ((size_t)b * 128 + t) * 256 + 64 * kvh + d0;
            kw = *(const u32x4*)kc; vw = *(const u32x4*)(kc + 8 * 128 * 256);
        } else {
            const int row = sample ? (SEQ + 64 * b + t - 128) : (64 * cid - 128 + t);
            float kf[8];
            if (row >= 0) { const bf16* src = F.big + (size_t)row * PITCH + C_K1 + 64 * kvh + d0; const u32x4 kr = *(const u32x4*)src; vw = *(const u32x4*)(src + 256);
                kf[0] = bflo(kr.x); kf[1] = bfhi(kr.x); kf[2] = bflo(kr.y); kf[3] = bfhi(kr.y); kf[4] = bflo(kr.z); kf[5] = bfhi(kr.z); kf[6] = bflo(kr.w); kf[7] = bfhi(kr.w); }
            else {
#pragma unroll
                for (int e = 0; e < 8; ++e) kf[e] = 0.f; }
            float ss = 0.f;
#pragma unroll
            for (int e = 0; e < 8; ++e) ss += kf[e] * kf[e];
            ss += __shfl_xor(ss, 1); ss += __shfl_xor(ss, 2); ss += __shfl_xor(ss, 4);
            const float inv = 1.0f / sqrtf(ss * (1.0f / 64.0f) + EPS);
            const f32x4 g0 = *(const f32x4*)(kgain + d0), g1 = *(const f32x4*)(kgain + d0 + 4), q0 = *(const f32x4*)(qgain + d0), q1 = *(const f32x4*)(qgain + d0 + 4);
            float kn[8] = {kf[0] * inv * g0.x, kf[1] * inv * g0.y, kf[2] * inv * g0.z, kf[3] * inv * g0.w, kf[4] * inv * g1.x, kf[5] * inv * g1.y, kf[6] * inv * g1.z, kf[7] * inv * g1.w};
            if (t >= 128 && (sample || cid >= 254)) {
                const size_t o = sample ? ((size_t)((b * 64 + (t - 128)) * 4 + kvh) * 64 + d0) : ((size_t)((row - (SEQ - 128)) * 4 + kvh) * 64 + d0);
                float* ko = F.out + (sample ? O_KS : O_KP) + o; float* vo = F.out + (sample ? O_VS : O_VP) + o;
                *(f32x4*)ko = (f32x4){kn[0], kn[1], kn[2], kn[3]}; *(f32x4*)(ko + 4) = (f32x4){kn[4], kn[5], kn[6], kn[7]};
                *(f32x4*)vo = (f32x4){bflo(vw.x), bfhi(vw.x), bflo(vw.y), bfhi(vw.y)}; *(f32x4*)(vo + 4) = (f32x4){bflo(vw.z), bfhi(vw.z), bflo(vw.w), bfhi(vw.w)};
            }
            kw = (u32x4){pk2(kn[0] * q0.x, kn[1] * q0.y), pk2(kn[2] * q0.z, kn[3] * q0.w), pk2(kn[4] * q1.x, kn[5] * q1.y), pk2(kn[6] * q1.z, kn[7] * q1.w)};
        }
        *(LAS u32x4*)(Ks + t * 72 + d0) = kw;
        LAS bf16* vt = Vs + d0 * 196 + t;
        vt[0] = (bf16)(vw.x & 0xffffu); vt[196] = (bf16)(vw.x >> 16); vt[2 * 196] = (bf16)(vw.y & 0xffffu); vt[3 * 196] = (bf16)(vw.y >> 16);
        vt[4 * 196] = (bf16)(vw.z & 0xffffu); vt[5 * 196] = (bf16)(vw.z >> 16); vt[6 * 196] = (bf16)(vw.w & 0xffffu); vt[7 * 196] = (bf16)(vw.w >> 16);
    }
    __syncthreads();
    {
        const int hq = 4 * kvh + (F.wave >> 1);
        bf16* qrow = F.big + (size_t)(64 * cid + 32 * (F.wave & 1) + (F.lane & 31)) * PITCH + C_Q1 + 64 * hq;
        const int lo = sample ? 0 : (128 - 64 * cid);
        attn_core<64, 6, 72, 196>(Ks, Vs, qrow, 0.125f, F.inp(24)[hq], true, lo, F.lane);
    }
    __syncthreads();
}

struct SchedT {
    pg8::TileOrder T; const char* A; const char* B; size_t astep, bstep;
    __device__ bool next(int i, pg8::Unit& u) const {
        const long L = (long)i * T.G + T.c;
        if (!T.tile(L, u.pm, u.pn)) return false;
        u.kind = 0; u.A = A + (size_t)u.pm * astep; u.B = B + (size_t)u.pn * bstep; return true;
    }
};
template <int MODE>
struct EpiRes {
    static constexpr bool PERM = false;
    const float* xp; const float* xs; float* out; bf16* big; float* rss;
    __device__ __forceinline__ void operator()(const f32x4 (&acc)[2][2][4][2], const pg8::Unit& u, int wr, int wc, int fr, int fq) const {
        asm volatile("" : "+v"(fr), "+v"(fq));
        const int row0 = u.pm * 256 + wr * 64 + fr, col0 = u.pn * 256 + wc * 32 + 4 * fq;
#pragma unroll
        for (int ai = 0; ai < 2; ++ai)
#pragma unroll
            for (int m = 0; m < 4; ++m) {
                const int row = row0 + ai * 128 + m * 16;
                const float* base = (row < SEQ ? xp + (size_t)row * D : xs + (size_t)(row - SEQ) * D);
                bf16* xb = big + (size_t)row * PITCH + C_XB; float ss = 0.f;
#pragma unroll
                for (int bj = 0; bj < 2; ++bj)
#pragma unroll
                    for (int n = 0; n < 2; ++n) {
                        const int c = col0 + bj * 128 + n * 16;
                        f32x4 x;
                        if (MODE == 0) x = *(const f32x4*)(base + c); else { const u32x2 r = *(const u32x2*)(xb + c); x = (f32x4){bflo(r.x), bfhi(r.x), bflo(r.y), bfhi(r.y)}; }
                        x = x + acc[ai][bj][m][n];
                        if (MODE == 2) *(f32x4*)(out + (size_t)row * D + c) = x;
                        else { *(u32x2*)(xb + c) = (u32x2){pk2(x.x, x.y), pk2(x.z, x.w)}; ss += (x.x * x.x + x.y * x.y) + (x.z * x.z + x.w * x.w); }
                    }
                if (MODE != 2) { ss += __shfl_xor(ss, 16); ss += __shfl_xor(ss, 32); if (fq == 0) atomicAdd(rss + row, ss); }
                asm volatile("" ::: "memory");
            }
    }
};
struct EpiSwiglu {
    static constexpr bool PERM = true;
    bf16* big; const float* rss;
    __device__ __forceinline__ void operator()(const f32x4 (&acc)[2][2][4][2], const pg8::Unit& u, int wr, int wc, int fr, int fq) const {
        asm volatile("" : "+v"(fr), "+v"(fq));
        const int row0 = u.pm * 256 + wr * 64 + fr, col = C_ACT + u.pn * 128 + wc * 32 + 8 * fq;
#pragma unroll
        for (int ai = 0; ai < 2; ++ai)
#pragma unroll
            for (int m = 0; m < 4; ++m) {
                const int row = row0 + ai * 128 + m * 16;
                const float inv = 1.0f / sqrtf(rss[row] * (1.0f / 1024.0f) + EPS);
                float a[8];
#pragma unroll
                for (int n = 0; n < 2; ++n)
#pragma unroll
                    for (int j = 0; j < 4; ++j) { const float g = acc[ai][0][m][n][j] * inv, up = acc[ai][1][m][n][j] * inv; a[4 * n + j] = silu_f(g) * up; }
                *(u32x4*)(big + (size_t)row * PITCH + col) = (u32x4){pk2(a[0], a[1]), pk2(a[2], a[3]), pk2(a[4], a[5]), pk2(a[6], a[7])};
            }
    }
};
struct EpiScale {
    static constexpr bool PERM = true;
    bf16* big; const float* rss; int colbase;
    __device__ __forceinline__ void operator()(const f32x4 (&acc)[2][2][4][2], const pg8::Unit& u, int wr, int wc, int fr, int fq) const {
        asm volatile("" : "+v"(fr), "+v"(fq));
        const int row0 = u.pm * 256 + wr * 64 + fr, col = colbase + u.pn * 256 + wc * 32 + 8 * fq;
#pragma unroll
        for (int ai = 0; ai < 2; ++ai)
#pragma unroll
            for (int m = 0; m < 4; ++m) {
                const int row = row0 + ai * 128 + m * 16;
                const float inv = 1.0f / sqrtf(rss[row] * (1.0f / 1024.0f) + EPS);
#pragma unroll
                for (int bj = 0; bj < 2; ++bj) {
                    const f32x4 v0 = acc[ai][bj][m][0] * inv, v1 = acc[ai][bj][m][1] * inv;
                    *(u32x4*)(big + (size_t)row * PITCH + col + bj * 128) = (u32x4){pk2(v0[0], v0[1]), pk2(v0[2], v0[3]), pk2(v1[0], v1[1]), pk2(v1[2], v1[3])};
                }
            }
    }
};
template <class Epi>
__device__ __forceinline__ void run_gemm(Frame& F, int nN, int K, int acol, size_t wofs, const Epi& E) {
    SchedT S; S.T.init(66, nN, F.G, F.bid); S.A = (const char*)(F.big + acol); S.B = (const char*)(F.ws + wofs); S.astep = (size_t)256 * PITCH * 2; S.bstep = (size_t)256 * K * 2;
    pg8::gemm_phase<Epi, SchedT>(F.lds, F.tid, K, PITCH, S, E);
}

__global__ void __launch_bounds__(512, 2) mega_fwd(Args args) {
    extern __shared__ __attribute__((aligned(16))) unsigned char lds_raw[];
    Frame F;
    F.lds = (LAS unsigned char*)lds_raw;
    F.tid = threadIdx.x; F.lane = F.tid & 63; F.wave = __builtin_amdgcn_readfirstlane(F.tid >> 6);
    F.G = gridDim.x; F.bid = blockIdx.x;
    F.ka = (const float* const*)__builtin_amdgcn_kernarg_segment_ptr(); F.out = args.out; F.ws = args.ws;
    F.ctl = (gu32*)(args.ws + WS_CTL);
    F.big = (bf16*)(args.ws + WS_BIG);
    volatile LAS unsigned* MISC = (volatile LAS unsigned*)(F.lds + MISC_OFF);
    if (F.tid < 64) MISC[F.tid] = 0u;
    __syncthreads();
    XcdBarrier bar = xcd_barrier_post((unsigned*)(F.ctl + CW_BAR), MISC + 8);
    unsigned long long t_probe0 = (PROBE_A == 0) ? __builtin_amdgcn_s_memrealtime() : 0ull, t_probe1 = 0; int phase_no = 0;
#define GRID_BAR() do { xcd_barrier(bar); PHASE_FENCE(); ++phase_no; if (PROBE_A >= 0) { if (phase_no == PROBE_A) t_probe0 = __builtin_amdgcn_s_memrealtime(); if (phase_no == PROBE_A + 1) t_probe1 = __builtin_amdgcn_s_memrealtime(); } } while (0)

    p0_prologue(F);
    GRID_BAR();
    if (LAST_PHASE < 1) return;
    {
        SchedP1 S; S.T.init(66, 19, F.G, F.bid); S.A = (const char*)F.out; S.B = (const char*)(F.ws + WS_WA); S.Amem = (const char*)(F.ws + WS_MEMB); S.Bmem = (const char*)(F.ws + WS_WMEM);
        EpiP1 E{F.big, (bf16*)(F.ws + WS_HALO), (float*)(F.ws + WS_BA), (const float*)(F.ws + WS_ROWSS0), (float*)(F.ws + WS_KVRAW), F.out};
        pg8::gemm_phase<EpiP1, SchedP1>(F.lds, F.tid, 1024, 1024, S, E);
    }
    GRID_BAR();
    if (LAST_PHASE < 2) return;
    fix_items(F, F.bid * 8 + F.wave, F.G * 8);
    { int last_hp = -1; for (int u = F.bid; u < NCH * 4; u += F.G) { if ((u & 3) != last_hp) { last_hp = u & 3; __syncthreads(); prep_load_cw(F, last_hp); __syncthreads(); } prep_unit(F, u >> 2, u & 3); } }
    GRID_BAR();
    if (LAST_PHASE < 3) return;
    for (int t = F.bid; t < 256; t += F.G) gdn_l1(F, t >> 3, t & 7);
    GRID_BAR();
    if (F.bid < 8) gdn_l2(F, F.bid, F.out + O_STATE_P + (size_t)F.bid * 16384);
    else if (F.bid < 72) { const int t = F.bid - 8, b = t >> 3, h = t & 7; gdn_scan(F, 256 + b, 1, h, F.inp(5) + (size_t)(b * 8 + h) * 16384, false, F.out + O_STATE_S + (size_t)(b * 8 + h) * 16384); }
    else for (int u = F.bid - 72; u < 288; u += F.G - 72) mem_attn_unit(F, 0, u, C_QM0);
    GRID_BAR();
    for (int t = F.bid; t < 256; t += F.G) { const int g = t >> 3, h = t & 7; gdn_scan(F, 8 * g, 8, h, g ? (const float*)(F.ws + WS_HSLOT) + ((size_t)(g - 1) * 8 + h) * 16384 : nullptr, true, nullptr); }
    GRID_BAR();
    if (LAST_PHASE < 4) return;
    float* rss1 = (float*)(F.ctl + CW_RSS1); float* rss2 = (float*)(F.ctl + CW_RSS2); float* rss3 = (float*)(F.ctl + CW_RSS3);
    { EpiRes<0> E{F.inp(0), F.inp(1), F.out, F.big, rss1}; run_gemm(F, 4, 1536, C_Z, WS_WOA, E); }
    if (F.bid >= 8) {
        LAS float* scr = (LAS float*)(F.lds + F.wave * 16384);
        for (int it = 7424 + (F.bid - 8) * 8 + F.wave; it < 13440; it += (F.G - 8) * 8) wt_item(F, it, scr);
    }
    GRID_BAR();
    { EpiSwiglu E{F.big, rss1}; run_gemm(F, 22, 1024, C_XB, WS_WGU0, E); }
    GRID_BAR();
    { EpiRes<1> E{nullptr, nullptr, F.out, F.big, rss2}; run_gemm(F, 4, 2816, C_ACT, WS_WD0, E); }
    GRID_BAR();
    if (LAST_PHASE < 8) return;
    { EpiScale E{F.big, rss2, C_Q1}; run_gemm(F, 8, 1024, C_XB, WS_WB, E); }
    GRID_BAR();
    for (int u = F.bid; u < 1056 + 288; u += F.G) { if (u < 1056) swa_unit(F, u >> 2, u & 3); else mem_attn_unit(F, 1, u - 1056, C_QM1); }
    GRID_BAR();
    { EpiRes<1> E{nullptr, nullptr, F.out, F.big, rss3}; run_gemm(F, 4, 1536, C_Q1, WS_WOB, E); }
    GRID_BAR();
    { EpiSwiglu E{F.big, rss3}; run_gemm(F, 22, 1024, C_XB, WS_WGU1, E); }
    GRID_BAR();
    { EpiRes<2> E{nullptr, nullptr, F.out, F.big, nullptr}; run_gemm(F, 4, 2816, C_ACT, WS_WD1, E); }
    if (PROBE_A >= 0) { GRID_BAR(); if (F.bid == 0 && F.tid == 0) F.out[0] += (float)(t_probe1 - t_probe0) * 1e-4f; }
#ifdef DBG_ZERO
    {
        const size_t gt = (size_t)F.bid * 512 + F.tid, GT = (size_t)F.G * 512;
        for (size_t i = gt; i < O_STATE_P; i += GT) F.out[i] = 0.f;
        for (size_t i = O_KP + gt; i < O_MEMK; i += GT) F.out[i] = 0.f;
        for (size_t i = O_STATE_P + gt; i < O_CONV_P; i += GT) F.out[i] *= 3.f;
    }
#endif
}

extern "C" void kernel_launch(void* const* d_in, const int* in_sizes, int n_in, void* d_out, int out_size, void* d_ws, size_t ws_size, hipStream_t stream) {
    static int grid = 0;
    if (grid == 0) {
        int dev = 0, cus = 0, per_cu = 0;
        if (n_in != 28 || ws_size < WS_END) { fprintf(stderr, "kernel_launch: unexpected n_in %d / ws %zu\n", n_in, ws_size); grid = -1; return; }
        if (hipGetDevice(&dev) != hipSuccess || hipDeviceGetAttribute(&cus, hipDeviceAttributeMultiprocessorCount, dev) != hipSuccess) { grid = -1; return; }
        if (hipFuncSetAttribute((const void*)mega_fwd, hipFuncAttributeMaxDynamicSharedMemorySize, LDS_BYTES) != hipSuccess) { fprintf(stderr, "kernel_launch: hipFuncSetAttribute failed\n"); grid = -1; return; }
        if (hipOccupancyMaxActiveBlocksPerMultiprocessor(&per_cu, (const void*)mega_fwd, 512, LDS_BYTES) != hipSuccess || per_cu < 1) { fprintf(stderr, "kernel_launch: occupancy query says %d\n", per_cu); per_cu = 1; }
        (void)hipGetLastError();
        grid = cus;
    }
    if (grid < 0) return;
    (void)hipMemsetAsync((char*)d_ws + WS_CTL, 0, CTL_ZERO_BYTES, stream);
    Args a{};
    for (int i = 0; i < 28; ++i) a.in[i] = (const float*)d_in[i];
    a.out = (float*)d_out; a.ws = (unsigned char*)d_ws;
    hipLaunchKernelGGL(mega_fwd, dim3(grid), dim3(512), LDS_BYTES, stream, a);
}
```
